# Optimizing an MI355X kernel written in HIP

```python
import math
import jax
import jax.numpy as jnp
from jax import lax
import numpy as np


D_MODEL = 1024
BATCH = 4
SEQ = 4096
DEPTH = 2

GRID_W = 64
CTX_LEN = 256
Q_BLOCK = 128
ROPE_THETA = 10000.0
NORM_EPS = 1e-6

MLA_HEADS = 8
MLA_Q_RANK = 384
MLA_KV_RANK = 256
MLA_NOPE = 64
MLA_ROPE = 32
MLA_V = 64
MLA_QK = MLA_NOPE + MLA_ROPE

SSD_HEADS = 16
SSD_HEAD_DIM = 64
SSD_INNER = SSD_HEADS * SSD_HEAD_DIM
SSD_GROUPS = 2
SSD_STATE = 128
SSD_CONV = 3
SSD_CHUNK = 128
SSD_CONV_CH = SSD_INNER + 2 * SSD_GROUPS * SSD_STATE

GQA_HEADS = 8
GQA_KV_HEADS = 2
GQA_HEAD_DIM = 64

N_BRANCH = 3
MLA_IN = MLA_Q_RANK + MLA_KV_RANK + MLA_ROPE
SSD_IN = SSD_INNER + SSD_CONV_CH + 2 * SSD_HEADS
GQA_IN = (GQA_HEADS + 2 * GQA_KV_HEADS) * GQA_HEAD_DIM
GATE_IN = N_BRANCH * D_MODEL
IN_WIDTH = MLA_IN + SSD_IN + GQA_IN + GATE_IN
MLA_OUT = MLA_HEADS * MLA_V
GQA_OUT = GQA_HEADS * GQA_HEAD_DIM
OUT_WIDTH = MLA_OUT + SSD_INNER + GQA_OUT

FFN_HIDDEN = -(-8 * D_MODEL // (3 * 256)) * 256
DEEPNORM_ALPHA = (2 * DEPTH) ** 0.25
DEEPNORM_BETA = (8 * DEPTH) ** -0.25

kernel_name = 'hybrid_mla_ssd_gqa_diffusion_block'


def layer_norm(x):
    xf = x.astype(jnp.float32)
    mu = jnp.mean(xf, axis=-1, keepdims=True)
    var = jnp.mean(jnp.square(xf - mu), axis=-1, keepdims=True)
    return ((xf - mu) * lax.rsqrt(var + NORM_EPS)).astype(x.dtype)


def layer_norm_affine(x, g, b):
    return layer_norm(x) * g + b


def rms_norm(x, g):
    xf = x.astype(jnp.float32)
    y = xf * lax.rsqrt(jnp.mean(jnp.square(xf), axis=-1, keepdims=True) + NORM_EPS)
    return (y * g).astype(x.dtype)


def axial_rope_tables(n_tokens, rot_dim):
    rows = n_tokens // GRID_W
    row = jnp.repeat(jnp.arange(rows), GRID_W)
    col = jnp.tile(jnp.arange(GRID_W), rows)
    n_freq = rot_dim // 4
    inv_freq = ROPE_THETA ** (-jnp.arange(n_freq, dtype=jnp.float32) / n_freq)
    ang = jnp.concatenate([row[:, None] * inv_freq, col[:, None] * inv_freq], axis=-1)
    return jnp.cos(ang), jnp.sin(ang)


def apply_rope(x, cos, sin):
    x1, x2 = jnp.split(x, 2, axis=-1)
    cos = cos[None, :, None, :].astype(x.dtype)
    sin = sin[None, :, None, :].astype(x.dtype)
    return jnp.concatenate([x1 * cos - x2 * sin, x1 * sin + x2 * cos], axis=-1)


def block_attention(q, k, v, scale):
    b, lq, hk, r, d = q.shape
    dv = v.shape[-1]
    n_blk = lq // Q_BLOCK
    qb = jnp.moveaxis(q.reshape(b, n_blk, Q_BLOCK, hk, r, d), 1, 0)

    def one_block(qi):
        s = jnp.einsum('bqhrd,bkhd->bhrqk', qi, k).astype(jnp.float32) * scale
        p = jax.nn.softmax(s, axis=-1).astype(v.dtype)
        return jnp.einsum('bhrqk,bkhd->bqhrd', p, v)

    o = lax.map(one_block, qb)
    return jnp.moveaxis(o, 0, 1).reshape(b, lq, hk * r * dv)


def mla_queries(p, w_uq, g_q, rope):
    b, l, _ = p.shape
    q = (rms_norm(p[..., :MLA_Q_RANK], g_q) @ w_uq).reshape(b, l, MLA_HEADS, MLA_QK)
    q_nope, q_rope = jnp.split(q, [MLA_NOPE], axis=-1)
    if rope is not None:
        q_rope = apply_rope(q_rope, *rope)
    return jnp.concatenate([q_nope, q_rope], axis=-1)[:, :, :, None, :]


def mla_keys_values(p, w_ukv, g_kv, rope):
    b, l, _ = p.shape
    ckv = p[..., MLA_Q_RANK:MLA_Q_RANK + MLA_KV_RANK]
    k_rope = p[..., MLA_Q_RANK + MLA_KV_RANK:][:, :, None, :]
    kv = (rms_norm(ckv, g_kv) @ w_ukv).reshape(b, l, MLA_HEADS, MLA_NOPE + MLA_V)
    k_nope, v = jnp.split(kv, [MLA_NOPE], axis=-1)
    if rope is not None:
        k_rope = apply_rope(k_rope, *rope)
    k = jnp.concatenate([k_nope, jnp.broadcast_to(k_rope, (b, l, MLA_HEADS, MLA_ROPE))], axis=-1)
    return k, v


def centred_depthwise_conv(u, w, bias):
    y = lax.conv_general_dilated(
        u, w[:, None, :].astype(u.dtype), window_strides=(1,),
        padding=[((SSD_CONV - 1) // 2, SSD_CONV // 2)],
        dimension_numbers=('NWC', 'WIO', 'NWC'), feature_group_count=u.shape[-1])
    return y + bias


def ssd_prepare(p, conv_w, conv_b, dt_bias):
    b, l, _ = p.shape
    z, xbc, dt = jnp.split(p, [SSD_INNER, SSD_INNER + SSD_CONV_CH], axis=-1)
    xbc = jax.nn.silu(centred_depthwise_conv(xbc, conv_w, conv_b))
    xs, bm, cm = jnp.split(xbc, [SSD_INNER, SSD_INNER + SSD_GROUPS * SSD_STATE], axis=-1)
    xs = xs.reshape(b, l, SSD_HEADS, SSD_HEAD_DIM)
    bm = bm.reshape(b, l, SSD_GROUPS, SSD_STATE)
    cm = cm.reshape(b, l, SSD_GROUPS, SSD_STATE)
    dt = jax.nn.softplus(dt.astype(jnp.float32) + dt_bias.reshape(-1).astype(jnp.float32))
    return z, xs, bm, cm, dt[..., :SSD_HEADS], dt[..., SSD_HEADS:]


def ssd_scan(x, dt, a, bm, cm, h0, return_y):
    b, l, h, p = x.shape
    g, n = bm.shape[-2:]
    r = h // g
    nc = l // SSD_CHUNK
    f32 = jnp.float32
    xdt = (x.astype(f32) * dt[..., None]).reshape(b, nc, SSD_CHUNK, g, r, p)
    bc = bm.astype(f32).reshape(b, nc, SSD_CHUNK, g, n)
    a_cum = jnp.cumsum((dt * a).reshape(b, nc, SSD_CHUNK, g, r), axis=2)
    decay_to_end = jnp.exp(a_cum[:, :, -1:] - a_cum)
    chunk_states = jnp.einsum('bckgn,bckgr,bckgrp->bcgrpn', bc, decay_to_end, xdt)
    chunk_decay = jnp.exp(a_cum[:, :, -1])

    def step(h_prev, inp):
        s, d = inp
        h_new = d[..., None, None] * h_prev + s
        return h_new, (h_prev if return_y else None)

    h_last, h_in = lax.scan(step, h0, (jnp.moveaxis(chunk_states, 1, 0), jnp.moveaxis(chunk_decay, 1, 0)))
    if not return_y:
        return None, h_last
    cc = cm.astype(f32).reshape(b, nc, SSD_CHUNK, g, n)
    seg = a_cum[:, :, :, None] - a_cum[:, :, None]
    in_order = jnp.tril(jnp.ones((SSD_CHUNK, SSD_CHUNK), bool))[None, None, :, :, None, None]
    decay = jnp.exp(jnp.where(in_order, seg, -jnp.inf))
    scores = jnp.einsum('bcqgn,bckgn->bcqkg', cc, bc)
    y_diag = jnp.einsum('bcqkg,bcqkgr,bckgrp->bcqgrp', scores, decay, xdt)
    y_off = jnp.einsum('bcqgn,bcgrpn,bcqgr->bcqgrp', cc, jnp.moveaxis(h_in, 0, 1), jnp.exp(a_cum))
    return (y_diag + y_off).reshape(b, l, h, p).astype(x.dtype), h_last


def ssd_branch(px, pc, conv_w, conv_b, a_log, dt_bias, d_skip, g_ssd, with_ctx):
    zx, xx, bx, cx, dtx_f, dtx_b = ssd_prepare(px, conv_w, conv_b, dt_bias)
    zc, xc, bc, cc, dtc_f, dtc_b = ssd_prepare(pc, conv_w, conv_b, dt_bias)
    a = -jnp.exp(a_log.astype(jnp.float32))
    b = px.shape[0]
    h0 = jnp.zeros((b, SSD_GROUPS, SSD_HEADS // SSD_GROUPS, SSD_HEAD_DIM, SSD_STATE), jnp.float32)
    fl = lambda t: jnp.flip(t, axis=1)
    yc_f, hc_f = ssd_scan(xc, dtc_f, a[0], bc, cc, h0, with_ctx)
    yc_b, hc_b = ssd_scan(fl(xc), fl(dtc_b), a[1], fl(bc), fl(cc), h0, with_ctx)
    yx_f, _ = ssd_scan(xx, dtx_f, a[0], bx, cx, hc_f, True)
    yx_b, _ = ssd_scan(fl(xx), fl(dtx_b), a[1], fl(bx), fl(cx), hc_b, True)

    def finish(y_f, y_b_rev, xs, z):
        y = y_f + fl(y_b_rev) + d_skip[:, None].astype(xs.dtype) * xs
        return rms_norm(y.reshape(z.shape) * jax.nn.silu(z), g_ssd)

    out_x = finish(yx_f, yx_b, xx, zx)
    out_c = finish(yc_f, yc_b, xc, zc) if with_ctx else None
    return out_x, out_c


def gqa_queries(p, g_q, rope):
    b, l, _ = p.shape
    q = rms_norm(p[..., :GQA_OUT].reshape(b, l, GQA_HEADS, GQA_HEAD_DIM), g_q)
    if rope is not None:
        q = apply_rope(q, *rope)
    return q.reshape(b, l, GQA_KV_HEADS, GQA_HEADS // GQA_KV_HEADS, GQA_HEAD_DIM)


def gqa_keys_values(p, g_k, rope):
    b, l, _ = p.shape
    kv_w = GQA_KV_HEADS * GQA_HEAD_DIM
    k = rms_norm(p[..., GQA_OUT:GQA_OUT + kv_w].reshape(b, l, GQA_KV_HEADS, GQA_HEAD_DIM), g_k)
    v = p[..., GQA_OUT + kv_w:].reshape(b, l, GQA_KV_HEADS, GQA_HEAD_DIM)
    if rope is not None:
        k = apply_rope(k, *rope)
    return k, v


def merge_branches(y_mla, y_ssd, y_gqa, gate_logits, b_gate, w_out):
    g = jax.nn.sigmoid((gate_logits + b_gate).astype(jnp.float32)).astype(y_mla.dtype)
    g_mla, g_ssd, g_gqa = jnp.split(g, N_BRANCH, axis=-1)
    w_mla, w_ssd, w_gqa = jnp.split(w_out, [MLA_OUT, MLA_OUT + SSD_INNER], axis=0)
    return g_mla * (y_mla @ w_mla) + g_ssd * (y_ssd @ w_ssd) + g_gqa * (y_gqa @ w_gqa)


def hybrid_mixer(hx, hc, rope_mla, rope_gqa, w_in, b_gate, w_uq, g_q_mla, w_ukv, g_kv_mla,
                 conv_w, conv_b, a_log, dt_bias, d_skip, g_ssd, g_q_gqa, g_k_gqa, w_out, with_ctx):
    cuts = [MLA_IN, MLA_IN + SSD_IN, MLA_IN + SSD_IN + GQA_IN]
    px_mla, px_ssd, px_gqa, px_gate = jnp.split(hx @ w_in, cuts, axis=-1)
    pc_mla, pc_ssd, pc_gqa, pc_gate = jnp.split(hc @ w_in, cuts, axis=-1)
    mla_scale = MLA_QK ** -0.5
    gqa_scale = GQA_HEAD_DIM ** -0.5

    kx, vx = mla_keys_values(px_mla, w_ukv, g_kv_mla, rope_mla)
    kc, vc = mla_keys_values(pc_mla, w_ukv, g_kv_mla, None)
    yx_mla = block_attention(mla_queries(px_mla, w_uq, g_q_mla, rope_mla),
                             jnp.concatenate([kc, kx], axis=1), jnp.concatenate([vc, vx], axis=1), mla_scale)
    yx_ssd, yc_ssd = ssd_branch(px_ssd, pc_ssd, conv_w, conv_b, a_log, dt_bias, d_skip, g_ssd, with_ctx)
    kx_g, vx_g = gqa_keys_values(px_gqa, g_k_gqa, rope_gqa)
    kc_g, vc_g = gqa_keys_values(pc_gqa, g_k_gqa, None)
    yx_gqa = block_attention(gqa_queries(px_gqa, g_q_gqa, rope_gqa),
                             jnp.concatenate([kc_g, kx_g], axis=1), jnp.concatenate([vc_g, vx_g], axis=1), gqa_scale)

    mx = merge_branches(yx_mla, yx_ssd, yx_gqa, px_gate, b_gate, w_out)
    mc = None
    if with_ctx:
        yc_mla = block_attention(mla_queries(pc_mla, w_uq, g_q_mla, None), kc, vc, mla_scale)
        yc_gqa = block_attention(gqa_queries(pc_gqa, g_q_gqa, None), kc_g, vc_g, gqa_scale)
        mc = merge_branches(yc_mla, yc_ssd, yc_gqa, pc_gate, b_gate, w_out)
    return mx, mc


def swiglu(h, w_ffn_in, w_ffn_out):
    gate, up = jnp.split(h @ w_ffn_in, 2, axis=-1)
    return (jax.nn.silu(gate) * up) @ w_ffn_out


def setup_inputs(seed: int = 0) -> dict:
    key = jax.random.key(seed)
    k = jax.random.split(key, 27)
    f32 = jnp.float32
    L = DEPTH

    def nrm(i, shape, scale):
        return jax.random.normal(k[i], shape, f32) * scale

    def gain(i, shape):
        return 1.0 + nrm(i, shape, 0.02)

    dt0 = jnp.exp(jax.random.uniform(k[15], (L, 2, SSD_HEADS), f32, math.log(1e-3), math.log(1e-1)))
    return {
        'x': nrm(0, (BATCH, SEQ, D_MODEL), 1.0),
        'c': nrm(1, (BATCH, D_MODEL), 1.0),
        'ctx': nrm(2, (BATCH, CTX_LEN, D_MODEL), 1.0),
        'c_ctx': nrm(3, (D_MODEL,), 1.0),
        'w_mod': nrm(4, (L, D_MODEL, 6 * D_MODEL), 0.5 * D_MODEL ** -0.5),
        'b_mod': nrm(5, (L, 6 * D_MODEL), 0.01),
        'w_in': nrm(6, (L, D_MODEL, IN_WIDTH), D_MODEL ** -0.5),
        'b_gate': nrm(7, (L, GATE_IN), 0.01),
        'w_uq': nrm(8, (L, MLA_Q_RANK, MLA_HEADS * MLA_QK), MLA_Q_RANK ** -0.5),
        'g_q_mla': gain(9, (L, MLA_Q_RANK)),
        'w_ukv': nrm(10, (L, MLA_KV_RANK, MLA_HEADS * (MLA_NOPE + MLA_V)), MLA_KV_RANK ** -0.5),
        'g_kv_mla': gain(11, (L, MLA_KV_RANK)),
        'conv_w': nrm(12, (L, SSD_CONV, SSD_CONV_CH), SSD_CONV ** -0.5),
        'conv_b': nrm(13, (L, SSD_CONV_CH), 0.01),
        'a_log': jnp.log(jax.random.uniform(k[14], (L, 2, SSD_HEADS), f32, 1.0, 16.0)),
        'dt_bias': dt0 + jnp.log(-jnp.expm1(-dt0)),
        'd_skip': gain(16, (L, SSD_HEADS)),
        'g_ssd': gain(17, (L, SSD_INNER)),
        'g_q_gqa': gain(18, (L, GQA_HEAD_DIM)),
        'g_k_gqa': gain(19, (L, GQA_HEAD_DIM)),
        'w_out': nrm(20, (L, OUT_WIDTH, D_MODEL), DEEPNORM_BETA * OUT_WIDTH ** -0.5),
        'ln1_g': gain(21, (L, D_MODEL)),
        'ln1_b': nrm(22, (L, D_MODEL), 0.01),
        'w_ffn_in': nrm(23, (L, D_MODEL, 2 * FFN_HIDDEN), D_MODEL ** -0.5),
        'w_ffn_out': nrm(24, (L, FFN_HIDDEN, D_MODEL), DEEPNORM_BETA * FFN_HIDDEN ** -0.5),
        'ln2_g': gain(25, (L, D_MODEL)),
        'ln2_b': nrm(26, (L, D_MODEL), 0.01),
    }


def reference(x, c, ctx, c_ctx, w_mod, b_mod, w_in, b_gate, w_uq, g_q_mla, w_ukv, g_kv_mla,
              conv_w, conv_b, a_log, dt_bias, d_skip, g_ssd, g_q_gqa, g_k_gqa, w_out,
              ln1_g, ln1_b, w_ffn_in, w_ffn_out, ln2_g, ln2_b):
    n_lat = x.shape[1]
    rope_mla = axial_rope_tables(n_lat, MLA_ROPE)
    rope_gqa = axial_rope_tables(n_lat, GQA_HEAD_DIM)
    silu_c = jax.nn.silu(c)[:, None, :]
    silu_cc = jax.nn.silu(c_ctx)
    xc = ctx
    for i in range(DEPTH):
        with_ctx = i < DEPTH - 1
        sh1, sc1, g1, sh2, sc2, g2 = jnp.split(silu_c @ w_mod[i] + b_mod[i], 6, axis=-1)
        csh1, csc1, cg1, csh2, csc2, cg2 = jnp.split(silu_cc @ w_mod[i] + b_mod[i], 6, axis=-1)
        hx = layer_norm(x) * (1 + sc1) + sh1
        hc = layer_norm(xc) * (1 + csc1) + csh1
        mx, mc = hybrid_mixer(hx, hc, rope_mla, rope_gqa, w_in[i], b_gate[i], w_uq[i], g_q_mla[i],
                              w_ukv[i], g_kv_mla[i], conv_w[i], conv_b[i], a_log[i], dt_bias[i],
                              d_skip[i], g_ssd[i], g_q_gqa[i], g_k_gqa[i], w_out[i], with_ctx)
        x = layer_norm_affine(DEEPNORM_ALPHA * x + g1 * mx, ln1_g[i], ln1_b[i])
        fx = swiglu(layer_norm(x) * (1 + sc2) + sh2, w_ffn_in[i], w_ffn_out[i])
        x = layer_norm_affine(DEEPNORM_ALPHA * x + g2 * fx, ln2_g[i], ln2_b[i])
        if with_ctx:
            xc = layer_norm_affine(DEEPNORM_ALPHA * xc + cg1 * mc, ln1_g[i], ln1_b[i])
            fc = swiglu(layer_norm(xc) * (1 + csc2) + csh2, w_ffn_in[i], w_ffn_out[i])
            xc = layer_norm_affine(DEEPNORM_ALPHA * xc + cg2 * fc, ln2_g[i], ln2_b[i])
    return x
```

```cpp
#include <hip/hip_runtime.h>
#include <hip/hip_cooperative_groups.h>
#include <cstdio>
namespace cg = cooperative_groups;

typedef unsigned short u16;
typedef __attribute__((ext_vector_type(8))) short bf16x8;
typedef __attribute__((ext_vector_type(4))) float f32x4;
#define DI __device__ __forceinline__

constexpr int D = 1024, NBATCH = 4, SEQ = 4096, CTXL = 256;
constexpr int TL = NBATCH * SEQ, TC = NBATCH * CTXL, T = TL + TC;
constexpr int NKEY = CTXL + SEQ;
constexpr int NCH = 34;
constexpr int IN_W = 7104, FFN_H = 2816;
constexpr int WINP = 4224;
constexpr float EPS = 1e-6f;
constexpr float ALPHA = 1.41421356237f;

constexpr size_t OFF_MODV = 0;
constexpr size_t OFF_COSM = OFF_MODV + 2 * 5 * 6144 * 4;
constexpr size_t OFF_SINM = OFF_COSM + 4096 * 16 * 4;
constexpr size_t OFF_COSG = OFF_SINM + 4096 * 16 * 4;
constexpr size_t OFF_SING = OFF_COSG + 4096 * 32 * 4;
constexpr size_t OFF_STATS = OFF_SING + 4096 * 32 * 4;
constexpr size_t OFF_CHDEC = OFF_STATS + (size_t)T * 2 * 4;
constexpr size_t OFF_XC = OFF_CHDEC + 2 * 4 * 34 * 16 * 4;
constexpr size_t OFF_W0 = OFF_XC + (size_t)TC * D * 4;
constexpr size_t OFF_W1 = OFF_W0 + (size_t)5632 * 1024 * 2;
constexpr size_t OFF_VTG = OFF_W1 + (size_t)1024 * 2816 * 2;
constexpr size_t OFF_R0 = OFF_VTG + (size_t)4 * 2 * 64 * NKEY * 2;
constexpr size_t SZ_T1024 = (size_t)T * 1024 * 2;
constexpr size_t SZ_XBC = (size_t)T * 1536 * 2;
constexpr size_t OFF_R1 = OFF_R0 + SZ_T1024 + SZ_XBC;
constexpr size_t OFF_R2 = OFF_R1 + SZ_T1024;
constexpr size_t OFF_R3 = OFF_R2 + SZ_XBC;
constexpr size_t OFF_R4 = OFF_R3 + (size_t)T * 32 * 4;
constexpr size_t OFF_BAR = OFF_R4 + SZ_XBC;
constexpr size_t WS_END = OFF_R4 + SZ_XBC;
constexpr size_t WS_TOTAL = OFF_BAR + 16384;
constexpr size_t OFF_H = OFF_R0;
constexpr size_t OFF_XR = OFF_R0 + SZ_T1024;
constexpr size_t OFF_QM = OFF_R0;
constexpr size_t OFF_KM = OFF_QM + (size_t)T * 768 * 2;
constexpr size_t OFF_VTM = OFF_KM + (size_t)T * 768 * 2;
constexpr size_t OFF_YMLA = OFF_VTM + (size_t)T * 512 * 2;
constexpr size_t OFF_S = OFF_R0;
constexpr size_t OFF_ACT = OFF_R0;
constexpr size_t OFF_Z = OFF_R1;
constexpr size_t OFF_XBC = OFF_R2;
constexpr size_t OFF_H2 = OFF_R2;
constexpr size_t OFF_DT = OFF_R3;
constexpr size_t OFF_PGQA = OFF_R4;
constexpr size_t OFF_PMLA = OFF_R4 + (size_t)T * 640 * 2;
constexpr size_t OFF_YGQA = OFF_R4 + SZ_T1024;
constexpr size_t OFF_YSSD = OFF_R4;
static_assert(OFF_YMLA + (size_t)T * 512 * 2 == OFF_R1, "R0 layout");
static_assert(OFF_PMLA + (size_t)T * 672 * 2 <= WS_END, "R4 layout");
static_assert(OFF_YGQA + (size_t)T * 512 * 2 == WS_END, "R4 layout");
static_assert((size_t)2 * 4 * 34 * 16 * 64 * 128 * 2 <= (size_t)T * (768 + 768 + 512) * 2, "S fits");
static_assert(OFF_ACT + (size_t)T * 2816 * 2 <= OFF_R2, "ACT fits");
constexpr size_t W0_UQ = (size_t)WINP * 1024;
constexpr size_t W0_UKV = W0_UQ + (size_t)768 * 384;
constexpr size_t W0_OUT = (size_t)3072 * 1024;

constexpr int SMEM_BYTES = 73728;

struct Params {
  const float *x, *c, *ctx, *c_ctx, *w_mod, *b_mod, *w_in, *b_gate, *w_uq, *g_q_mla, *w_ukv, *g_kv_mla, *conv_w,
      *conv_b, *a_log, *dt_bias, *d_skip, *g_ssd, *g_q_gqa, *g_k_gqa, *w_out, *ln1_g, *ln1_b, *w_ffn_in, *w_ffn_out,
      *ln2_g, *ln2_b;
  float* out;
  char* ws;
  int ph0, ph1;
};

DI int threadIdx_x_raw() { return (int)__builtin_amdgcn_workitem_id_x(); }
DI int opaque_tid() { int t = threadIdx_x_raw(); asm volatile("" : "+v"(t)); return t; }
#define TIDX opaque_tid()
typedef _Float16 f16x2_t __attribute__((ext_vector_type(2)));
typedef _Float16 f16x8_t __attribute__((ext_vector_type(8)));
DI float bflo(unsigned w) { return (float)__builtin_bit_cast(f16x2_t, w)[0]; }
DI float bfhi(unsigned w) { return (float)__builtin_bit_cast(f16x2_t, w)[1]; }
DI float bf2f(u16 h) { return bflo((unsigned)h); }
typedef __bf16 bf16x2_t __attribute__((ext_vector_type(2)));
typedef float f32x2_t __attribute__((ext_vector_type(2)));
DI unsigned pk2(float lo, float hi) {
  f32x2_t f = {lo, hi};
  f16x2_t b = __builtin_convertvector(f, f16x2_t);
  return __builtin_bit_cast(unsigned, b);
}
DI u16 f2bf(float f) { return (u16)(pk2(f, 0.f) & 0xffffu); }
DI unsigned pkh2(float lo, float hi) {
  f32x2_t f = {lo, hi};
  f16x2_t b = __builtin_convertvector(f, f16x2_t);
  return __builtin_bit_cast(unsigned, b);
}
DI u16 f2h(float f) { return (u16)(pkh2(f, 0.f) & 0xffffu); }
DI float siluf(float x) { return x / (1.f + __expf(-x)); }
DI float sigmf(float x) { return 1.f / (1.f + __expf(-x)); }
DI void st_bf4(u16* p, f32x4 v) {
  uint2 u;
  u.x = pk2(v[0], v[1]);
  u.y = pk2(v[2], v[3]);
  *(uint2*)p = u;
}
DI void st_h4(u16* p, f32x4 v) {
  uint2 u;
  u.x = pkh2(v[0], v[1]);
  u.y = pkh2(v[2], v[3]);
  *(uint2*)p = u;
}
template <bool F16>
DI f32x4 mma16(bf16x8 a, bf16x8 b, f32x4 c) {
  return __builtin_amdgcn_mfma_f32_16x16x32_f16(__builtin_bit_cast(f16x8_t, a), __builtin_bit_cast(f16x8_t, b), c, 0, 0, 0);
}
DI int row_mod(int r) { return r < TL ? (r >> 12) : 4; }
DI int row_batch(int r) { return r < TL ? (r >> 12) : ((r - TL) >> 8); }
DI int row_key(int r) { return r < TL ? CTXL + (r & 4095) : ((r - TL) & 255); }
DI float quad_max(float v) {
  auto r = __builtin_amdgcn_permlane16_swap(__float_as_uint(v), __float_as_uint(v), false, false);
  v = fmaxf(__uint_as_float(r[0]), __uint_as_float(r[1]));
  auto s = __builtin_amdgcn_permlane32_swap(__float_as_uint(v), __float_as_uint(v), false, false);
  return fmaxf(__uint_as_float(s[0]), __uint_as_float(s[1]));
}
DI float quad_sum(float v) {
  auto r = __builtin_amdgcn_permlane16_swap(__float_as_uint(v), __float_as_uint(v), false, false);
  v = __uint_as_float(r[0]) + __uint_as_float(r[1]);
  auto s = __builtin_amdgcn_permlane32_swap(__float_as_uint(v), __float_as_uint(v), false, false);
  return __uint_as_float(s[0]) + __uint_as_float(s[1]);
}
DI float wave_sum(float v) {
#pragma unroll
  for (int o = 32; o > 0; o >>= 1) v += __shfl_xor(v, o);
  return v;
}

#define GAS __attribute__((address_space(1)))
#define LAS3 __attribute__((address_space(3)))
template <int NI, bool F16 = false>
DI void gemm_core(const u16* __restrict__ A, int lda, const u16* __restrict__ B, int ldb, int K, f32x4 (&acc)[4][NI],
                  u16* smem) {
  constexpr int BN = 32 * NI;
  constexpr int NBL = BN / 32;
  char* sA = (char*)smem;
  char* sB = sA + 2 * 16384;
  const int tid = TIDX, lane = tid & 63, wid = tid >> 6, wm = wid >> 1, wn = wid & 1;
  const int lr = lane & 15, lq = lane >> 4;
  const int r8 = tid >> 3, gc = (tid & 7) ^ (r8 & 7);
  const u16* Ap = A + (size_t)r8 * lda + gc * 8;
  const u16* Bp = B + (size_t)r8 * ldb + gc * 8;
  const int nk = K >> 6;
#define GEMM_ISSUE(KT, BUF)                                                                                         \
  {                                                                                                                 \
    const int ko_ = (KT) * 64;                                                                                      \
    _Pragma("unroll") for (int i = 0; i < 4; ++i)                                                                   \
        __builtin_amdgcn_global_load_lds((const GAS unsigned*)(Ap + (size_t)(32 * i) * lda + ko_),                  \
                                         (LAS3 unsigned*)(sA + (BUF) * 16384 + i * 4096 + tid * 16), 16, 0, 0);     \
    _Pragma("unroll") for (int i = 0; i < NBL; ++i)                                                                 \
        __builtin_amdgcn_global_load_lds((const GAS unsigned*)(Bp + (size_t)(32 * i) * ldb + ko_),                  \
                                         (LAS3 unsigned*)(sB + (BUF) * (BN * 128) + i * 4096 + tid * 16), 16, 0, 0); \
  }
  GEMM_ISSUE(0, 0)
  asm volatile("s_waitcnt vmcnt(0)" ::: "memory");
  __builtin_amdgcn_s_barrier();
  const int x0 = ((0 + lq) ^ (lr & 7)) << 4, x1 = ((4 + lq) ^ (lr & 7)) << 4;
  const unsigned la = (unsigned)(size_t)((LAS3 char*)(sA + (wm * 64 + lr) * 128));
  const unsigned lb = (unsigned)(size_t)((LAS3 char*)(sB + (wn * 16 * NI + lr) * 128));
  const unsigned la0 = la + x0, la1 = la + x1, lb0 = lb + x0, lb1 = lb + x1;
#define LDSR(dst, addr, off) asm volatile("ds_read_b128 %0, %1 offset:%2" : "=v"(dst) : "v"(addr), "n"(off))
#define GEMM_HALF(BUF, LA, LB)                                                                             \
  {                                                                                                        \
    bf16x8 a0[4], b0[NI];                                                                                  \
    LDSR(a0[0], LA, (BUF) * 16384 + 0 * 2048); LDSR(a0[1], LA, (BUF) * 16384 + 1 * 2048);                  \
    LDSR(a0[2], LA, (BUF) * 16384 + 2 * 2048); LDSR(a0[3], LA, (BUF) * 16384 + 3 * 2048);                  \
    LDSR(b0[0], LB, (BUF) * (BN * 128) + 0 * 2048); LDSR(b0[1], LB, (BUF) * (BN * 128) + 1 * 2048);        \
    if (NI == 4) { LDSR(b0[NI - 2], LB, (BUF) * (BN * 128) + 2 * 2048); LDSR(b0[NI - 1], LB, (BUF) * (BN * 128) + 3 * 2048); } \
    if (NI == 4) asm volatile("s_waitcnt lgkmcnt(0)" : "+v"(a0[0]), "+v"(a0[1]), "+v"(a0[2]), "+v"(a0[3]), "+v"(b0[0]), "+v"(b0[1]), "+v"(b0[NI - 2]), "+v"(b0[NI - 1])); \
    else asm volatile("s_waitcnt lgkmcnt(0)" : "+v"(a0[0]), "+v"(a0[1]), "+v"(a0[2]), "+v"(a0[3]), "+v"(b0[0]), "+v"(b0[1])); \
    _Pragma("unroll") for (int mi = 0; mi < 4; ++mi)                                                       \
        _Pragma("unroll") for (int ni = 0; ni < NI; ++ni)                                                  \
            acc[mi][ni] = mma16<F16>(b0[ni], a0[mi], acc[mi][ni]);                                         \
  }
#define GEMM_COMPUTE(BUF) GEMM_HALF(BUF, la0, lb0) GEMM_HALF(BUF, la1, lb1)
  for (int kt = 0; kt < nk; kt += 2) {
    GEMM_ISSUE(kt + 1, 1)
    GEMM_COMPUTE(0)
    asm volatile("s_waitcnt vmcnt(0)" ::: "memory");
    __builtin_amdgcn_s_barrier();
    if (kt + 2 < nk) GEMM_ISSUE(kt + 2, 0)
    GEMM_COMPUTE(1)
    asm volatile("s_waitcnt vmcnt(0)" ::: "memory");
    __builtin_amdgcn_s_barrier();
  }
#undef GEMM_COMPUTE
#undef GEMM_HALF
#undef LDSR
#undef GEMM_ISSUE
}

template <int NI>
DI void zero_acc(f32x4 (&acc)[4][NI]) {
#pragma unroll
  for (int i = 0; i < 4; ++i)
#pragma unroll
    for (int j = 0; j < NI; ++j) acc[i][j] = (f32x4){0.f, 0.f, 0.f, 0.f};
}

DI void tile_xcd(int j, int x, int mc, int NT, int& mt, int& nt) {
  const int h0 = (mc + 3) >> 2;
  const int per = h0 * NT, blk = j / per, rem = j - blk * per;
  const int hb = (mc - blk * h0) < h0 ? (mc - blk * h0) : h0;
  const int ml = blk * h0 + rem % hb;
  nt = rem / hb;
  mt = ml * 8 + x;
}
#define XCD_TILE_LOOP(MT_, NT_) for (int j_ = blockIdx.x >> 3; j_ < ((MT_) >> 3) * (NT_); j_ += gridDim.x >> 3)
DI void tile_mn(int t, int MT, int NT, int& mt, int& nt) {
  const int per = 16 * NT;
  const int grp = t / per, rem = t - grp * per;
  const int gsz = (MT - grp * 16) < 16 ? (MT - grp * 16) : 16;
  mt = grp * 16 + rem % gsz;
  nt = rem / gsz;
}

struct MapIdent { int base; DI int operator()(int r) const { return base + r; } };
struct MapInproj {
  DI int operator()(int r) const {
    if (r < 768) return r < 672 ? r : -1;
    if (r < 1792) return 672 + (r - 768);
    if (r < 3328) return 1696 + (r - 1792);
    if (r < 3456) return (r - 3328) < 32 ? 3232 + (r - 3328) : -1;
    return 3264 + (r - 3456);
  }
};
struct MapFfnIn {
  DI int operator()(int r) const {
    const int q = r >> 5, s = r & 31;
    return s < 16 ? 16 * q + s : FFN_H + 16 * q + (s - 16);
  }
};
template <class Map, bool F16 = false>
DI void cvt_tile(const float* __restrict__ src, int ldsrc, u16* __restrict__ dst, int K, int r0, int k0,
                 const float* kscale, Map map, float* tile) {
  const int tid = TIDX;
  {
    const int rl = tid & 63;
    const int sc = map(r0 + rl);
#pragma unroll 4
    for (int i = 0; i < 16; ++i) {
      const int kl = (tid >> 6) + 4 * i;
      tile[kl * 65 + rl] = sc >= 0 ? src[(size_t)(k0 + kl) * ldsrc + sc] : 0.f;
    }
  }
  __syncthreads();
  {
    const int kl = tid & 63;
    const float s = kscale ? kscale[k0 + kl] : 1.f;
#pragma unroll 4
    for (int i = 0; i < 16; ++i) {
      const int rl = (tid >> 6) + 4 * i;
      dst[(size_t)(r0 + rl) * K + k0 + kl] = F16 ? f2h(tile[kl * 65 + rl] * s) : f2bf(tile[kl * 65 + rl] * s);
    }
  }
  __syncthreads();
}
DI void cvt_inproj_set(const Params& p, int l, float* tile) {
  u16* W0 = (u16*)(p.ws + OFF_W0);
  constexpr int N1 = (WINP / 64) * 16, N2 = (768 / 64) * (384 / 64), N3 = (1024 / 64) * (256 / 64);
  for (int it = blockIdx.x; it < N1 + N2 + N3; it += gridDim.x) {
    if (it < N1) {
      cvt_tile(p.w_in + (size_t)l * 1024 * IN_W, IN_W, W0, 1024, (it >> 4) * 64, (it & 15) * 64, nullptr, MapInproj(), tile);
    } else if (it < N1 + N2) {
      const int j = it - N1;
      cvt_tile(p.w_uq + (size_t)l * 384 * 768, 768, W0 + W0_UQ, 384, (j / 6) * 64, (j % 6) * 64, p.g_q_mla + l * 384, MapIdent{0}, tile);
    } else {
      const int j = it - N1 - N2;
      cvt_tile(p.w_ukv + (size_t)l * 256 * 1024, 1024, W0 + W0_UKV, 256, (j >> 2) * 64, (j & 3) * 64, p.g_kv_mla + l * 256, MapIdent{0}, tile);
    }
  }
}
DI void cvt_merge_set(const Params& p, int l, float* tile) {
  u16* W0 = (u16*)(p.ws + OFF_W0);
  constexpr int N1 = (3072 / 64) * 16, N2 = (1024 / 64) * (2048 / 64);
  for (int it = blockIdx.x; it < N1 + N2; it += gridDim.x) {
    if (it < N1) {
      cvt_tile(p.w_in + (size_t)l * 1024 * IN_W, IN_W, W0, 1024, (it >> 4) * 64, (it & 15) * 64, nullptr, MapIdent{4032}, tile);
    } else {
      const int j = it - N1;
      cvt_tile(p.w_out + (size_t)l * 2048 * 1024, 1024, W0 + W0_OUT, 2048, (j >> 5) * 64, (j & 31) * 64, nullptr, MapIdent{0}, tile);
    }
  }
}
DI void cvt_ffn_set(const Params& p, int l, float* tile) {
  u16* W0 = (u16*)(p.ws + OFF_W0);
  u16* W1 = (u16*)(p.ws + OFF_W1);
  constexpr int N1 = (5632 / 64) * 16, N2 = (1024 / 64) * (2816 / 64);
  for (int it = blockIdx.x; it < N1 + N2; it += gridDim.x) {
    if (it < N1) {
      cvt_tile<MapFfnIn, true>(p.w_ffn_in + (size_t)l * 1024 * 5632, 5632, W0, 1024, (it >> 4) * 64, (it & 15) * 64, nullptr, MapFfnIn(), tile);
    } else {
      const int j = it - N1;
      cvt_tile<MapIdent, true>(p.w_ffn_out + (size_t)l * 2816 * 1024, 1024, W1, 2816, (j / 44) * 64, (j % 44) * 64, nullptr, MapIdent{0}, tile);
    }
  }
}

DI void phase_prologue(const Params& p, float* smf) {
  const int tid = TIDX;
  float* sc = smf;
  float* red = smf + 5 * 1024;
  for (int i = tid; i < 5 * 1024; i += 256) {
    const int r = i >> 10, k = i & 1023;
    const float v = r < 4 ? p.c[r * 1024 + k] : p.c_ctx[k];
    sc[i] = siluf(v);
  }
  __syncthreads();
  float* modv = (float*)(p.ws + OFF_MODV);
  for (int it = blockIdx.x; it < 2 * 192; it += gridDim.x) {
    const int l = it / 192, n0 = (it % 192) * 32;
    const int col = tid & 31, kg = tid >> 5;
    float a[5] = {0.f, 0.f, 0.f, 0.f, 0.f};
    const float* w = p.w_mod + (size_t)l * 1024 * 6144 + n0 + col;
    for (int k = kg * 128; k < kg * 128 + 128; ++k) {
      const float wv = w[(size_t)k * 6144];
#pragma unroll
      for (int r = 0; r < 5; ++r) a[r] += sc[r * 1024 + k] * wv;
    }
#pragma unroll
    for (int r = 0; r < 5; ++r) red[(kg * 5 + r) * 32 + col] = a[r];
    __syncthreads();
    if (tid < 160) {
      const int r = tid >> 5, cl = tid & 31;
      float s = p.b_mod[l * 6144 + n0 + cl];
#pragma unroll
      for (int g = 0; g < 8; ++g) s += red[(g * 5 + r) * 32 + cl];
      modv[(l * 5 + r) * 6144 + n0 + cl] = s;
    }
    __syncthreads();
  }
  float* cosM = (float*)(p.ws + OFF_COSM);
  float* sinM = (float*)(p.ws + OFF_SINM);
  float* cosG = (float*)(p.ws + OFF_COSG);
  float* sinG = (float*)(p.ws + OFF_SING);
  const int gtid = blockIdx.x * 256 + tid, gn = gridDim.x * 256;
  for (int i = gtid; i < 4096 * 48; i += gn) {
    const int pos = i / 48, j = i % 48;
    const int prow = pos >> 6, pcol = pos & 63;
    float ang;
    if (j < 16) {
      const int f = j & 7;
      const float inv = exp2f(-(float)f * (13.287712379549449f / 8.f));
      ang = (float)(j < 8 ? prow : pcol) * inv;
    } else {
      const int jj = j - 16, f = jj & 15;
      const float inv = exp2f(-(float)f * (13.287712379549449f / 16.f));
      ang = (float)(jj < 16 ? prow : pcol) * inv;
    }
    float rev = ang * 0.15915494309189535f;
    rev -= floorf(rev);
    const float sn = __builtin_amdgcn_sinf(rev), cs = __builtin_amdgcn_cosf(rev);
    if (j < 16) { cosM[pos * 16 + j] = cs; sinM[pos * 16 + j] = sn; }
    else { cosG[pos * 32 + j - 16] = cs; sinG[pos * 32 + j - 16] = sn; }
  }
}

template <int MODE>
DI void ln_rows(const Params& p, int nrows, const float* srcL, const float* srcC, float* dstL, float* dstC,
                const float* lng, const float* lnb, const float* modl, int sh_off, int sc_off, u16* H, bool writeH, bool h16 = false) {
  const int lane = TIDX & 63;
  const int gw = (blockIdx.x * 256 + TIDX) >> 6, nw = (gridDim.x * 256) >> 6;
  for (int r = gw; r < nrows; r += nw) {
    const float* src = r < TL ? srcL + (size_t)r * D : srcC + (size_t)(r - TL) * D;
    f32x4 v[4];
#pragma unroll
    for (int i = 0; i < 4; ++i) v[i] = *(const f32x4*)(src + i * 256 + lane * 4);
    float s = 0.f;
#pragma unroll
    for (int i = 0; i < 4; ++i) s += v[i][0] + v[i][1] + v[i][2] + v[i][3];
    float mu = wave_sum(s) * (1.f / D);
    float q = 0.f;
#pragma unroll
    for (int i = 0; i < 4; ++i)
#pragma unroll
      for (int j = 0; j < 4; ++j) { const float d = v[i][j] - mu; q += d * d; }
    float rstd = rsqrtf(wave_sum(q) * (1.f / D) + EPS);
    if (MODE == 1) {
      float* dst = r < TL ? dstL + (size_t)r * D : dstC + (size_t)(r - TL) * D;
      s = 0.f;
#pragma unroll
      for (int i = 0; i < 4; ++i) {
        const f32x4 g = *(const f32x4*)(lng + i * 256 + lane * 4), b = *(const f32x4*)(lnb + i * 256 + lane * 4);
#pragma unroll
        for (int j = 0; j < 4; ++j) { v[i][j] = (v[i][j] - mu) * rstd * g[j] + b[j]; s += v[i][j]; }
        *(f32x4*)(dst + i * 256 + lane * 4) = v[i];
      }
      if (!writeH) continue;
      mu = wave_sum(s) * (1.f / D);
      q = 0.f;
#pragma unroll
      for (int i = 0; i < 4; ++i)
#pragma unroll
        for (int j = 0; j < 4; ++j) { const float d = v[i][j] - mu; q += d * d; }
      rstd = rsqrtf(wave_sum(q) * (1.f / D) + EPS);
    }
    const float* mrow = modl + row_mod(r) * 6144;
#pragma unroll
    for (int i = 0; i < 4; ++i) {
      const f32x4 sh = *(const f32x4*)(mrow + sh_off + i * 256 + lane * 4), sc = *(const f32x4*)(mrow + sc_off + i * 256 + lane * 4);
      f32x4 h;
#pragma unroll
      for (int j = 0; j < 4; ++j) h[j] = (v[i][j] - mu) * rstd * (1.f + sc[j]) + sh[j];
      if (h16) st_h4(H + (size_t)r * D + i * 256 + lane * 4, h); else st_bf4(H + (size_t)r * D + i * 256 + lane * 4, h);
    }
  }
}

DI void phase_inproj(const Params& p, int l, u16* smem) {
  const u16* H = (const u16*)(p.ws + OFF_H);
  const u16* W = (const u16*)(p.ws + OFF_W0);
  u16* Pmla = (u16*)(p.ws + OFF_PMLA);
  u16* Z = (u16*)(p.ws + OFF_Z);
  u16* XR = (u16*)(p.ws + OFF_XR);
  float* DT = (float*)(p.ws + OFF_DT);
  u16* Pgqa = (u16*)(p.ws + OFF_PGQA);
  u16* VtG = (u16*)(p.ws + OFF_VTG);
  const float* cosG = (const float*)(p.ws + OFF_COSG);
  const float* sinG = (const float*)(p.ws + OFF_SING);
  const int tid = TIDX, lane = tid & 63, wid = tid >> 6, wm = wid >> 1, wn = wid & 1, lr = lane & 15, lq = lane >> 4;
  constexpr int MT = T / 128, NT = WINP / 128;
  XCD_TILE_LOOP(MT, NT) {
    int mt, nt;
    tile_xcd(j_, blockIdx.x & 7, MT >> 3, NT, mt, nt);
    f32x4 acc[4][4];
    zero_acc<4>(acc);
    gemm_core<4>(H + (size_t)mt * 128 * 1024, 1024, W + (size_t)nt * 128 * 1024, 1024, 1024, acc, smem);
    const int rbase = mt * 128 + wm * 64 + lr;
    const int cw = wn * 64 + lq * 4;
    if (nt < 6) {
#pragma unroll
      for (int mi = 0; mi < 4; ++mi)
#pragma unroll
        for (int ni = 0; ni < 4; ++ni) {
          const int col = nt * 128 + cw + ni * 16;
          if (col < 672) st_bf4(Pmla + (size_t)(rbase + mi * 16) * 672 + col, acc[mi][ni]);
        }
    } else if (nt < 14) {
#pragma unroll
      for (int mi = 0; mi < 4; ++mi)
#pragma unroll
        for (int ni = 0; ni < 4; ++ni) st_bf4(Z + (size_t)(rbase + mi * 16) * 1024 + (nt - 6) * 128 + cw + ni * 16, acc[mi][ni]);
    } else if (nt < 26) {
#pragma unroll
      for (int mi = 0; mi < 4; ++mi)
#pragma unroll
        for (int ni = 0; ni < 4; ++ni) st_bf4(XR + (size_t)(rbase + mi * 16) * 1536 + (nt - 14) * 128 + cw + ni * 16, acc[mi][ni]);
    } else if (nt == 26) {
      if (wn == 0) {
#pragma unroll
        for (int mi = 0; mi < 4; ++mi)
#pragma unroll
          for (int ni = 0; ni < 2; ++ni) *(f32x4*)(DT + (size_t)(rbase + mi * 16) * 32 + lq * 4 + ni * 16) = acc[mi][ni];
      }
    } else if (nt < 32) {
      const float* g = (nt < 31) ? p.g_q_gqa + l * 64 : p.g_k_gqa + l * 64;
      const int dcol = (nt < 31) ? (nt - 27) * 128 + wn * 64 : 512 + wn * 64;
      f32x4 gv[4];
#pragma unroll
      for (int ni = 0; ni < 4; ++ni) gv[ni] = *(const f32x4*)(g + ni * 16 + lq * 4);
#pragma unroll
      for (int mi = 0; mi < 4; ++mi) {
        const int row = rbase + mi * 16;
        float ss = 0.f;
#pragma unroll
        for (int ni = 0; ni < 4; ++ni)
#pragma unroll
          for (int j = 0; j < 4; ++j) ss += acc[mi][ni][j] * acc[mi][ni][j];
        ss = quad_sum(ss);
        const float rstd = rsqrtf(ss * (1.f / 64.f) + EPS);
        f32x4 y[4];
#pragma unroll
        for (int ni = 0; ni < 4; ++ni)
#pragma unroll
          for (int j = 0; j < 4; ++j) y[ni][j] = acc[mi][ni][j] * rstd * gv[ni][j];
        if (row < TL) {
          const int pos = row & 4095;
#pragma unroll
          for (int ni = 0; ni < 2; ++ni) {
            const f32x4 cs = *(const f32x4*)(cosG + pos * 32 + ni * 16 + lq * 4), sn = *(const f32x4*)(sinG + pos * 32 + ni * 16 + lq * 4);
#pragma unroll
            for (int j = 0; j < 4; ++j) {
              const float x1 = y[ni][j], x2 = y[ni + 2][j];
              y[ni][j] = x1 * cs[j] - x2 * sn[j];
              y[ni + 2][j] = x1 * sn[j] + x2 * cs[j];
            }
          }
        }
#pragma unroll
        for (int ni = 0; ni < 4; ++ni) st_bf4(Pgqa + (size_t)row * 640 + dcol + ni * 16 + lq * 4, y[ni]);
      }
    } else {
#pragma unroll
      for (int mi = 0; mi < 4; ++mi) {
        const int row = rbase + mi * 16;
        const int b = row_batch(row), key = row_key(row);
        u16* vt = VtG + ((size_t)(b * 2 + wn) * 64) * NKEY + key;
#pragma unroll
        for (int ni = 0; ni < 4; ++ni)
#pragma unroll
          for (int j = 0; j < 4; ++j) vt[(size_t)(ni * 16 + lq * 4 + j) * NKEY] = f2bf(acc[mi][ni][j]);
      }
    }
  }
}

DI unsigned conv_word(unsigned w0, unsigned w1, unsigned w2, const float* cw, const float* cb, int ch) {
  const float lo = cw[ch] * bflo(w0) + cw[1536 + ch] * bflo(w1) + cw[3072 + ch] * bflo(w2) + cb[ch];
  const float hi = cw[ch + 1] * bfhi(w0) + cw[1536 + ch + 1] * bfhi(w1) + cw[3072 + ch + 1] * bfhi(w2) + cb[ch + 1];
  return pk2(siluf(lo), siluf(hi));
}
DI float sq_word(unsigned w) { const float x = bflo(w), y = bfhi(w); return x * x + y * y; }
DI void phase_c1(const Params& p, int l) {
  const u16* XR = (const u16*)(p.ws + OFF_XR);
  u16* XBC = (u16*)(p.ws + OFF_XBC);
  float* DT = (float*)(p.ws + OFF_DT);
  const u16* Pmla = (const u16*)(p.ws + OFF_PMLA);
  float* stats = (float*)(p.ws + OFF_STATS);
  const float* cw = p.conv_w + (size_t)l * 3 * 1536;
  const float* cb = p.conv_b + (size_t)l * 1536;
  const int gtid = blockIdx.x * 256 + TIDX, gn = gridDim.x * 256;
  for (int i = gtid; i < (T / 32) * 192; i += gn) {
    const int seg = i / 192, ch0 = (i % 192) * 8;
    const int row0 = seg * 32;
    bool first, last;
    if (row0 < TL) { const int pl = row0 & 4095; first = pl == 0; last = pl == 4096 - 32; }
    else { const int pj = (row0 - TL) & 255; first = pj == 0; last = pj == 256 - 32; }
    float w0[8], w1[8], w2[8], bb[8];
#pragma unroll
    for (int k = 0; k < 8; ++k) { w0[k] = cw[ch0 + k]; w1[k] = cw[1536 + ch0 + k]; w2[k] = cw[3072 + ch0 + k]; bb[k] = cb[ch0 + k]; }
    const uint4 z4 = make_uint4(0u, 0u, 0u, 0u);
    uint4 up = z4;
    if (!first) up = *(const uint4*)(XR + (size_t)(row0 - 1) * 1536 + ch0);
    uint4 uc = *(const uint4*)(XR + (size_t)row0 * 1536 + ch0);
#pragma unroll 4
    for (int r = 0; r < 32; ++r) {
      const int row = row0 + r;
      uint4 un = z4;
      if (r < 31 || !last) un = *(const uint4*)(XR + (size_t)(row + 1) * 1536 + ch0);
      uint4 ov;
      {
        const float lo = w0[0] * bflo(up.x) + w1[0] * bflo(uc.x) + w2[0] * bflo(un.x) + bb[0];
        const float hi = w0[1] * bfhi(up.x) + w1[1] * bfhi(uc.x) + w2[1] * bfhi(un.x) + bb[1];
        ov.x = pk2(siluf(lo), siluf(hi));
      }
      {
        const float lo = w0[2] * bflo(up.y) + w1[2] * bflo(uc.y) + w2[2] * bflo(un.y) + bb[2];
        const float hi = w0[3] * bfhi(up.y) + w1[3] * bfhi(uc.y) + w2[3] * bfhi(un.y) + bb[3];
        ov.y = pk2(siluf(lo), siluf(hi));
      }
      {
        const float lo = w0[4] * bflo(up.z) + w1[4] * bflo(uc.z) + w2[4] * bflo(un.z) + bb[4];
        const float hi = w0[5] * bfhi(up.z) + w1[5] * bfhi(uc.z) + w2[5] * bfhi(un.z) + bb[5];
        ov.z = pk2(siluf(lo), siluf(hi));
      }
      {
        const float lo = w0[6] * bflo(up.w) + w1[6] * bflo(uc.w) + w2[6] * bflo(un.w) + bb[6];
        const float hi = w0[7] * bfhi(up.w) + w1[7] * bfhi(uc.w) + w2[7] * bfhi(un.w) + bb[7];
        ov.w = pk2(siluf(lo), siluf(hi));
      }
      *(uint4*)(XBC + (size_t)row * 1536 + ch0) = ov;
      up = uc;
      uc = un;
    }
  }
  for (int i = gtid; i < T * 32; i += gn) {
    const float v = DT[i] + p.dt_bias[l * 32 + (i & 31)];
    const float e = __expf(-fabsf(v));
    const float lp = e < 0.01f ? e * (1.f - e * (0.5f - e * (1.f / 3.f))) : __logf(1.f + e);
    DT[i] = fmaxf(v, 0.f) + lp;
  }
  const int lane = TIDX & 63;
  const int gw = gtid >> 6, nw = gn >> 6;
  for (int r = gw; r < T; r += nw) {
    float sq = 0.f, sk = 0.f;
    if (lane < 48) {
      const uint4 u = *(const uint4*)(Pmla + (size_t)r * 672 + lane * 8);
      sq = sq_word(u.x) + sq_word(u.y) + sq_word(u.z) + sq_word(u.w);
    }
    if (lane < 32) {
      const uint4 u = *(const uint4*)(Pmla + (size_t)r * 672 + 384 + lane * 8);
      sk = sq_word(u.x) + sq_word(u.y) + sq_word(u.z) + sq_word(u.w);
    }
    sq = wave_sum(sq);
    sk = wave_sum(sk);
    if (lane == 0) {
      stats[r * 2] = rsqrtf(sq * (1.f / 384.f) + EPS);
      stats[r * 2 + 1] = rsqrtf(sk * (1.f / 256.f) + EPS);
    }
  }
}

DI void phase_c2(const Params& p, int l, u16* smem) {
  const u16* Pmla = (const u16*)(p.ws + OFF_PMLA);
  const u16* W0 = (const u16*)(p.ws + OFF_W0);
  u16* Qm = (u16*)(p.ws + OFF_QM);
  u16* Km = (u16*)(p.ws + OFF_KM);
  u16* VtM = (u16*)(p.ws + OFF_VTM);
  const float* stats = (const float*)(p.ws + OFF_STATS);
  const float* cosM = (const float*)(p.ws + OFF_COSM);
  const float* sinM = (const float*)(p.ws + OFF_SINM);
  const int tid = TIDX, lane = tid & 63, wid = tid >> 6, wm = wid >> 1, wn = wid & 1, lr = lane & 15, lq = lane >> 4;
  constexpr int MT = T / 128;
  XCD_TILE_LOOP(MT, 14) {
    f32x4 acc[4][4];
    zero_acc<4>(acc);
    int mt, nt;
    tile_xcd(j_, blockIdx.x & 7, MT >> 3, 14, mt, nt);
    if (nt < 6) {
      gemm_core<4>(Pmla + (size_t)mt * 128 * 672, 672, W0 + W0_UQ + (size_t)nt * 128 * 384, 384, 384, acc, smem);
      const int rbase = mt * 128 + wm * 64 + lr;
      const int c0 = nt * 128 + wn * 64;
      const int g0 = c0 >> 4;
#pragma unroll
      for (int mi = 0; mi < 4; ++mi) {
        const int row = rbase + mi * 16;
        const float rs = stats[row * 2];
        f32x4 y[4];
#pragma unroll
        for (int ni = 0; ni < 4; ++ni) y[ni] = acc[mi][ni] * rs;
        if (row < TL) {
          const int pos = row & 4095;
          const f32x4 cs = *(const f32x4*)(cosM + pos * 16 + lq * 4), sn = *(const f32x4*)(sinM + pos * 16 + lq * 4);
#pragma unroll
          for (int ni = 0; ni < 3; ++ni) {
            if ((g0 + ni) % 6 == 4) {
#pragma unroll
              for (int j = 0; j < 4; ++j) {
                const float x1 = y[ni][j], x2 = y[ni + 1][j];
                y[ni][j] = x1 * cs[j] - x2 * sn[j];
                y[ni + 1][j] = x1 * sn[j] + x2 * cs[j];
              }
            }
          }
        }
#pragma unroll
        for (int ni = 0; ni < 4; ++ni) st_bf4(Qm + (size_t)row * 768 + c0 + ni * 16 + lq * 4, y[ni]);
      }
    } else {
      nt -= 6;
      gemm_core<4>(Pmla + (size_t)mt * 128 * 672 + 384, 672, W0 + W0_UKV + (size_t)nt * 128 * 256, 256, 256, acc, smem);
      const int rbase = mt * 128 + wm * 64 + lr;
#pragma unroll
      for (int mi = 0; mi < 4; ++mi) {
        const int row = rbase + mi * 16;
        const float rs = stats[row * 2 + 1];
        if (wn == 0) {
#pragma unroll
          for (int ni = 0; ni < 4; ++ni) st_bf4(Km + (size_t)row * 768 + nt * 96 + ni * 16 + lq * 4, acc[mi][ni] * rs);
        } else {
          const int b = row_batch(row), key = row_key(row);
          u16* vt = VtM + ((size_t)(b * 8 + nt) * 64) * NKEY + key;
#pragma unroll
          for (int ni = 0; ni < 4; ++ni)
#pragma unroll
            for (int j = 0; j < 4; ++j) vt[(size_t)(ni * 16 + lq * 4 + j) * NKEY] = f2bf(acc[mi][ni][j] * rs);
        }
      }
    }
  }
  const int gtid = blockIdx.x * 256 + tid, gn = gridDim.x * 256;
  for (int i = gtid; i < T * 16; i += gn) {
    const int row = i >> 4, j = i & 15;
    float x1 = bf2f(Pmla[(size_t)row * 672 + 640 + j]), x2 = bf2f(Pmla[(size_t)row * 672 + 656 + j]);
    if (row < TL) {
      const int pos = row & 4095;
      const float cs = cosM[pos * 16 + j], sn = sinM[pos * 16 + j];
      const float a = x1 * cs - x2 * sn, b = x1 * sn + x2 * cs;
      x1 = a; x2 = b;
    }
    const u16 h1 = f2bf(x1), h2 = f2bf(x2);
#pragma unroll
    for (int h = 0; h < 8; ++h) {
      Km[(size_t)row * 768 + h * 96 + 64 + j] = h1;
      Km[(size_t)row * 768 + h * 96 + 80 + j] = h2;
    }
  }
}

template <int DQK, bool NOMAX>
DI void attn_item(const u16* __restrict__ Q, int ldq, int qoff, const u16* __restrict__ Kp, int ldk, int koff,
                  const u16* __restrict__ Vt, u16* __restrict__ Y, int yoff, int b, int qrow0, int nkt, float sl2, float c0, u16* smem) {
  constexpr int KS = DQK / 32;
  constexpr int KB = KS * 4096, STG = KB + 8192;
  char* sbase = (char*)smem;
  const int tid = TIDX, lane = tid & 63, wid = tid >> 6, lr = lane & 15, lq = lane >> 4;
  bf16x8 qf[2][KS];
#pragma unroll
  for (int qi = 0; qi < 2; ++qi)
#pragma unroll
    for (int ks = 0; ks < KS; ++ks)
      qf[qi][ks] = *(const bf16x8*)(Q + (size_t)(qrow0 + wid * 32 + qi * 16 + lr) * ldq + qoff + ks * 32 + lq * 8);
  f32x4 o[4][2];
#pragma unroll
  for (int i = 0; i < 4; ++i)
#pragma unroll
    for (int j = 0; j < 2; ++j) o[i][j] = (f32x4){0.f, 0.f, 0.f, 0.f};
  float mrun[2] = {-1e30f, -1e30f}, lrun[2] = {0.f, 0.f};
  const int drow = tid >> 2, dch = (tid & 3) ^ ((drow >> 2) & 3);
  const u16* vsrc = Vt + (size_t)drow * NKEY + dch * 8;
#define ATT_ISSUE(KT, BUF)                                                                                           \
  {                                                                                                                  \
    const int kt_ = (KT) < nkt ? (KT) : nkt - 1;                                                                     \
    const int r0_ = kt_ < 4 ? TL + b * CTXL + kt_ * 64 : b * SEQ + (kt_ - 4) * 64;                                   \
    const u16* ksrc_ = Kp + (size_t)(r0_ + drow) * ldk + koff + dch * 8;                                             \
    _Pragma("unroll") for (int ks = 0; ks < KS; ++ks)                                                                \
        __builtin_amdgcn_global_load_lds((const GAS unsigned*)(ksrc_ + ks * 32),                                     \
                                         (LAS3 unsigned*)(sbase + (BUF) * STG + ks * 4096 + tid * 16), 16, 0, 0);    \
    _Pragma("unroll") for (int u = 0; u < 2; ++u)                                                                    \
        __builtin_amdgcn_global_load_lds((const GAS unsigned*)(vsrc + kt_ * 64 + u * 32),                            \
                                         (LAS3 unsigned*)(sbase + (BUF) * STG + KB + u * 4096 + tid * 16), 16, 0, 0); \
  }
  const unsigned lbase = (unsigned)(size_t)((LAS3 char*)sbase);
  const unsigned kaddr = lbase + lr * 64 + ((lq ^ ((lr >> 2) & 3)) << 4);
  const unsigned vaddr0 = lbase + KB + lr * 64 + ((((lq >> 1)) ^ ((lr >> 2) & 3)) << 4) + (lq & 1) * 8;
  const unsigned vaddr1 = lbase + KB + lr * 64 + ((((lq >> 1) + 2) ^ ((lr >> 2) & 3)) << 4) + (lq & 1) * 8;
#define LDSR128(dst, addr, off) asm volatile("ds_read_b128 %0, %1 offset:%2" : "=v"(dst) : "v"(addr), "n"(off))
#define LDSR64(dst, addr, off) asm volatile("ds_read_b64 %0, %1 offset:%2" : "=v"(dst) : "v"(addr), "n"(off))
#define ATT_COMPUTE(BUF)                                                                                             \
  {                                                                                                                  \
    f32x4 s[4][2];                                                                                                   \
    _Pragma("unroll") for (int kk = 0; kk < 4; ++kk) {                                                               \
      bf16x8 kf[KS];                                                                                                 \
      LDSR128(kf[0], kaddr, (BUF) * STG + 0 * 4096 + kk * 1024);                                                     \
      LDSR128(kf[1], kaddr, (BUF) * STG + 1 * 4096 + kk * 1024);                                                     \
      if (KS == 3) LDSR128(kf[KS - 1], kaddr, (BUF) * STG + 2 * 4096 + kk * 1024);                                   \
      if (KS == 3) asm volatile("s_waitcnt lgkmcnt(0)" : "+v"(kf[0]), "+v"(kf[1]), "+v"(kf[KS - 1]));                \
      else asm volatile("s_waitcnt lgkmcnt(0)" : "+v"(kf[0]), "+v"(kf[1]));                                          \
      s[kk][0] = (f32x4){0.f, 0.f, 0.f, 0.f};                                                                        \
      s[kk][1] = (f32x4){0.f, 0.f, 0.f, 0.f};                                                                        \
      _Pragma("unroll") for (int ks = 0; ks < KS; ++ks) {                                                            \
        s[kk][0] = mma16<true>(kf[ks], qf[0][ks], s[kk][0]);                    \
        s[kk][1] = mma16<true>(kf[ks], qf[1][ks], s[kk][1]);                    \
      }                                                                                                              \
    }                                                                                                                \
    uint2 vlo[2][4], vhi[2][4];                                                                                      \
    _Pragma("unroll") for (int u = 0; u < 2; ++u) {                                                                  \
      LDSR64(vlo[u][0], vaddr0, (BUF) * STG + u * 4096 + 0 * 1024); LDSR64(vhi[u][0], vaddr1, (BUF) * STG + u * 4096 + 0 * 1024); \
      LDSR64(vlo[u][1], vaddr0, (BUF) * STG + u * 4096 + 1 * 1024); LDSR64(vhi[u][1], vaddr1, (BUF) * STG + u * 4096 + 1 * 1024); \
      LDSR64(vlo[u][2], vaddr0, (BUF) * STG + u * 4096 + 2 * 1024); LDSR64(vhi[u][2], vaddr1, (BUF) * STG + u * 4096 + 2 * 1024); \
      LDSR64(vlo[u][3], vaddr0, (BUF) * STG + u * 4096 + 3 * 1024); LDSR64(vhi[u][3], vaddr1, (BUF) * STG + u * 4096 + 3 * 1024); \
    }                                                                                                                \
    bf16x8 pf[2][2];                                                                                                 \
    _Pragma("unroll") for (int qi = 0; qi < 2; ++qi) {                                                               \
      float ps = 0.f;                                                                                                \
      float pv[4][4];                                                                                                \
      if (NOMAX) {                                                                                                   \
        _Pragma("unroll") for (int kk = 0; kk < 4; ++kk)                                                             \
            _Pragma("unroll") for (int j = 0; j < 4; ++j) {                                                          \
          const float e = __builtin_amdgcn_exp2f(s[kk][qi][j] * sl2 - c0);                                           \
          pv[kk][j] = e;                                                                                             \
          ps += e;                                                                                                   \
        }                                                                                                            \
      } else {                                                                                                       \
        float mx = -1e30f;                                                                                           \
        _Pragma("unroll") for (int kk = 0; kk < 4; ++kk)                                                             \
            _Pragma("unroll") for (int j = 0; j < 4; ++j) mx = fmaxf(mx, s[kk][qi][j]);                              \
        mx = quad_max(mx);                                                                                           \
        const float mnew = fmaxf(mrun[qi], mx * sl2);                                                                \
        const float alpha = __builtin_amdgcn_exp2f(mrun[qi] - mnew);                                                 \
        mrun[qi] = mnew;                                                                                             \
        _Pragma("unroll") for (int kk = 0; kk < 4; ++kk)                                                             \
            _Pragma("unroll") for (int j = 0; j < 4; ++j) {                                                          \
          const float e = __builtin_amdgcn_exp2f(s[kk][qi][j] * sl2 - mnew);                                         \
          pv[kk][j] = e;                                                                                             \
          ps += e;                                                                                                   \
        }                                                                                                            \
        if (__builtin_amdgcn_ballot_w64(alpha != 1.0f)) {                                                            \
          lrun[qi] *= alpha;                                                                                         \
          _Pragma("unroll") for (int dt = 0; dt < 4; ++dt) o[dt][qi] *= alpha;                                       \
        }                                                                                                            \
      }                                                                                                              \
      lrun[qi] += ps;                                                                                                \
      _Pragma("unroll") for (int u = 0; u < 2; ++u) {                                                                \
        union { bf16x8 v; unsigned w[4]; } pk;                                                                       \
        pk.w[0] = pk2(pv[2 * u][0], pv[2 * u][1]);                                                                   \
        pk.w[1] = pk2(pv[2 * u][2], pv[2 * u][3]);                                                                   \
        pk.w[2] = pk2(pv[2 * u + 1][0], pv[2 * u + 1][1]);                                                           \
        pk.w[3] = pk2(pv[2 * u + 1][2], pv[2 * u + 1][3]);                                                           \
        pf[qi][u] = pk.v;                                                                                            \
      }                                                                                                              \
    }                                                                                                                \
    asm volatile("s_waitcnt lgkmcnt(0)"                                                                              \
                 : "+v"(vlo[0][0]), "+v"(vlo[0][1]), "+v"(vlo[0][2]), "+v"(vlo[0][3]), "+v"(vhi[0][0]), "+v"(vhi[0][1]), \
                   "+v"(vhi[0][2]), "+v"(vhi[0][3]), "+v"(vlo[1][0]), "+v"(vlo[1][1]), "+v"(vlo[1][2]), "+v"(vlo[1][3]), \
                   "+v"(vhi[1][0]), "+v"(vhi[1][1]), "+v"(vhi[1][2]), "+v"(vhi[1][3]));                              \
    __builtin_amdgcn_s_setprio(1);                                                                                   \
    _Pragma("unroll") for (int u = 0; u < 2; ++u)                                                                    \
        _Pragma("unroll") for (int dt = 0; dt < 4; ++dt) {                                                           \
      union { bf16x8 v; uint2 h[2]; } vf;                                                                            \
      vf.h[0] = vlo[u][dt];                                                                                          \
      vf.h[1] = vhi[u][dt];                                                                                          \
      o[dt][0] = mma16<true>(vf.v, pf[0][u], o[dt][0]);                         \
      o[dt][1] = mma16<true>(vf.v, pf[1][u], o[dt][1]);                         \
    }                                                                                                                \
    __builtin_amdgcn_s_setprio(0);                                                                                   \
  }
  if (DQK == 64 && NOMAX) {
    f32x4 sc[4][2], sn[4][2];
#define ATT_KREAD(BUF)                                                                                               \
    _Pragma("unroll") for (int kk = 0; kk < 4; ++kk) {                                                               \
      LDSR128(kf[kk][0], kaddr, (BUF) * STG + 0 * 4096 + kk * 1024);                                                 \
      LDSR128(kf[kk][1], kaddr, (BUF) * STG + 1 * 4096 + kk * 1024);                                                 \
    }
#define ATT_VREAD(BUF)                                                                                               \
    _Pragma("unroll") for (int u = 0; u < 2; ++u) {                                                                  \
      LDSR64(vlo[u][0], vaddr0, (BUF) * STG + u * 4096 + 0 * 1024); LDSR64(vhi[u][0], vaddr1, (BUF) * STG + u * 4096 + 0 * 1024); \
      LDSR64(vlo[u][1], vaddr0, (BUF) * STG + u * 4096 + 1 * 1024); LDSR64(vhi[u][1], vaddr1, (BUF) * STG + u * 4096 + 1 * 1024); \
      LDSR64(vlo[u][2], vaddr0, (BUF) * STG + u * 4096 + 2 * 1024); LDSR64(vhi[u][2], vaddr1, (BUF) * STG + u * 4096 + 2 * 1024); \
      LDSR64(vlo[u][3], vaddr0, (BUF) * STG + u * 4096 + 3 * 1024); LDSR64(vhi[u][3], vaddr1, (BUF) * STG + u * 4096 + 3 * 1024); \
    }
#define ATT_KWAIT()                                                                                                  \
    asm volatile("s_waitcnt lgkmcnt(0)" : "+v"(kf[0][0]), "+v"(kf[0][1]), "+v"(kf[1][0]), "+v"(kf[1][1]), "+v"(kf[2][0]), "+v"(kf[2][1]), "+v"(kf[3][0]), "+v"(kf[3][1]));
#define ATT_VWAIT()                                                                                                  \
    asm volatile("s_waitcnt lgkmcnt(0)"                                                                              \
                 : "+v"(vlo[0][0]), "+v"(vlo[0][1]), "+v"(vlo[0][2]), "+v"(vlo[0][3]), "+v"(vhi[0][0]), "+v"(vhi[0][1]), \
                   "+v"(vhi[0][2]), "+v"(vhi[0][3]), "+v"(vlo[1][0]), "+v"(vlo[1][1]), "+v"(vlo[1][2]), "+v"(vlo[1][3]), \
                   "+v"(vhi[1][0]), "+v"(vhi[1][1]), "+v"(vhi[1][2]), "+v"(vhi[1][3]));
#define ATT_SMMA(s)                                                                                                  \
    _Pragma("unroll") for (int kk = 0; kk < 4; ++kk) {                                                               \
      s[kk][0] = (f32x4){0.f, 0.f, 0.f, 0.f};                                                                        \
      s[kk][1] = (f32x4){0.f, 0.f, 0.f, 0.f};                                                                        \
      _Pragma("unroll") for (int ks = 0; ks < 2; ++ks) {                                                             \
        s[kk][0] = mma16<true>(kf[kk][ks], qf[0][ks], s[kk][0]);                                                     \
        s[kk][1] = mma16<true>(kf[kk][ks], qf[1][ks], s[kk][1]);                                                     \
      }                                                                                                              \
    }
#define ATT_STEP2(KT, ST, SN)                                                                                        \
    if ((KT) < nkt) {                                                                                                \
      asm volatile("s_waitcnt vmcnt(0)" ::: "memory");                                                               \
      __builtin_amdgcn_s_barrier();                                                                                  \
      ATT_ISSUE((KT) + 2, ((ST) + 2) % 3)                                                                            \
      bf16x8 kf[4][2];                                                                                               \
      uint2 vlo[2][4], vhi[2][4];                                                                                    \
      if ((KT) + 1 < nkt) { ATT_KREAD(SN) } else { ATT_KREAD(ST) }                                                   \
      ATT_KWAIT()                                                                                                    \
      ATT_VREAD(ST)                                                                                                  \
      ATT_SMMA(sn)                                                                                                   \
      bf16x8 pf[2][2];                                                                                               \
      _Pragma("unroll") for (int qi = 0; qi < 2; ++qi) {                                                             \
        float ps = 0.f;                                                                                              \
        float pv[4][4];                                                                                              \
        _Pragma("unroll") for (int kk = 0; kk < 4; ++kk)                                                             \
            _Pragma("unroll") for (int j = 0; j < 4; ++j) {                                                          \
          const float e = __builtin_amdgcn_exp2f(sc[kk][qi][j] * sl2 - c0);                                          \
          pv[kk][j] = e;                                                                                             \
          ps += e;                                                                                                   \
        }                                                                                                            \
        lrun[qi] += ps;                                                                                              \
        _Pragma("unroll") for (int u = 0; u < 2; ++u) {                                                              \
          union { bf16x8 v; unsigned w[4]; } pk;                                                                     \
          pk.w[0] = pk2(pv[2 * u][0], pv[2 * u][1]);                                                                 \
          pk.w[1] = pk2(pv[2 * u][2], pv[2 * u][3]);                                                                 \
          pk.w[2] = pk2(pv[2 * u + 1][0], pv[2 * u + 1][1]);                                                         \
          pk.w[3] = pk2(pv[2 * u + 1][2], pv[2 * u + 1][3]);                                                         \
          pf[qi][u] = pk.v;                                                                                          \
        }                                                                                                            \
      }                                                                                                              \
      ATT_VWAIT()                                                                                                    \
      __builtin_amdgcn_s_setprio(1);                                                                                 \
      _Pragma("unroll") for (int u = 0; u < 2; ++u)                                                                  \
          _Pragma("unroll") for (int dt = 0; dt < 4; ++dt) {                                                         \
        union { bf16x8 v; uint2 h[2]; } vf;                                                                          \
        vf.h[0] = vlo[u][dt];                                                                                        \
        vf.h[1] = vhi[u][dt];                                                                                        \
        o[dt][0] = mma16<true>(vf.v, pf[0][u], o[dt][0]);                                                            \
        o[dt][1] = mma16<true>(vf.v, pf[1][u], o[dt][1]);                                                            \
      }                                                                                                              \
      __builtin_amdgcn_s_setprio(0);                                                                                 \
      _Pragma("unroll") for (int kk = 0; kk < 4; ++kk) { sc[kk][0] = sn[kk][0]; sc[kk][1] = sn[kk][1]; }             \
    }
    ATT_ISSUE(0, 0)
    ATT_ISSUE(1, 1)
    asm volatile("s_waitcnt vmcnt(%0)" ::"n"(KS + 2) : "memory");
    __builtin_amdgcn_s_barrier();
    {
      bf16x8 kf[4][2];
      ATT_KREAD(0)
      asm volatile("s_waitcnt lgkmcnt(0)" : "+v"(kf[0][0]), "+v"(kf[0][1]), "+v"(kf[1][0]), "+v"(kf[1][1]), "+v"(kf[2][0]), "+v"(kf[2][1]), "+v"(kf[3][0]), "+v"(kf[3][1]));
      ATT_SMMA(sc)
    }
    for (int kt = 0; kt < nkt; kt += 3) {
      ATT_STEP2(kt, 0, 1)
      ATT_STEP2(kt + 1, 1, 2)
      ATT_STEP2(kt + 2, 2, 0)
    }
    asm volatile("s_waitcnt vmcnt(0)" ::: "memory");
    __builtin_amdgcn_s_barrier();
#undef ATT_STEP2
#undef ATT_SMMA
#undef ATT_VWAIT
#undef ATT_KWAIT
#undef ATT_VREAD
#undef ATT_KREAD
  } else {
#define ATT_STEP(KT, ST)                                                                                             \
  if ((KT) < nkt) {                                                                                                  \
    asm volatile("s_waitcnt vmcnt(%0)" ::"n"(KS + 2) : "memory");                                                    \
    __builtin_amdgcn_s_barrier();                                                                                    \
    ATT_ISSUE((KT) + 2, ((ST) + 2) % 3)                                                                              \
    ATT_COMPUTE(ST)                                                                                                  \
  }
  ATT_ISSUE(0, 0)
  ATT_ISSUE(1, 1)
  for (int kt = 0; kt < nkt; kt += 3) {
    ATT_STEP(kt, 0)
    ATT_STEP(kt + 1, 1)
    ATT_STEP(kt + 2, 2)
  }
  asm volatile("s_waitcnt vmcnt(0)" ::: "memory");
  __builtin_amdgcn_s_barrier();
  }
#undef ATT_STEP
#undef ATT_COMPUTE
#undef ATT_ISSUE
#undef LDSR128
#undef LDSR64
#pragma unroll
  for (int qi = 0; qi < 2; ++qi) {
    const float lt = quad_sum(lrun[qi]);
    const float inv = 1.f / lt;
    const int row = qrow0 + wid * 32 + qi * 16 + lr;
#pragma unroll
    for (int dt = 0; dt < 4; ++dt) st_bf4(Y + (size_t)row * 512 + yoff + dt * 16 + lq * 4, o[dt][qi] * inv);
  }
}

DI void phase_attn(const Params& p, int l, bool with_ctx, u16* smem) {
  const u16* Qm = (const u16*)(p.ws + OFF_QM);
  const u16* Km = (const u16*)(p.ws + OFF_KM);
  const u16* VtM = (const u16*)(p.ws + OFF_VTM);
  u16* Ymla = (u16*)(p.ws + OFF_YMLA);
  const u16* Pgqa = (const u16*)(p.ws + OFF_PGQA);
  const u16* VtG = (const u16*)(p.ws + OFF_VTG);
  u16* Ygqa = (u16*)(p.ws + OFF_YGQA);
  const float sl2_mla = 0.10206207261596575f * 1.4426950408889634f;
  const float sl2_gqa = 0.125f * 1.4426950408889634f;
  float c0_gqa;
  {
    const int ln = TIDX & 63;
    float gq = fabsf(p.g_q_gqa[l * 64 + ln]), gk = fabsf(p.g_k_gqa[l * 64 + ln]);
#pragma unroll
    for (int o = 32; o > 0; o >>= 1) { gq = fmaxf(gq, __shfl_xor(gq, o)); gk = fmaxf(gk, __shfl_xor(gk, o)); }
    const float bound = 8.f * gq * gk * 1.01f;
    c0_gqa = fmaxf(0.f, bound - 10.f) * 1.4426950408889634f;
  }
  const int xcd = blockIdx.x & 7, slots = gridDim.x >> 3;
  const int per_xcd = 256 + (with_ctx ? 16 : 0);
  for (int q = blockIdx.x >> 3; q < per_xcd; q += slots) {
    int kind, b, h, qrow0, nkt;
    if (q < 128) {
      const int P = xcd * 4 + (q >> 5);
      kind = 0; b = P >> 3; h = P & 7;
      qrow0 = b * SEQ + (q & 31) * 128;
      nkt = NKEY / 64;
    } else if (q < 256) {
      const int q2 = q - 128;
      kind = 1; b = xcd >> 1; h = (xcd & 1) * 4 + (q2 >> 5);
      qrow0 = b * SEQ + (q2 & 31) * 128;
      nkt = NKEY / 64;
    } else {
      const int q3 = q - 256;
      kind = q3 & 1;
      const int j = xcd * 8 + (q3 >> 1);
      const int qt = j & 1; h = (j >> 1) & 7; b = j >> 4;
      qrow0 = TL + b * CTXL + qt * 128;
      nkt = CTXL / 64;
    }
    if (kind == 0)
      attn_item<96, false>(Qm, 768, h * 96, Km, 768, h * 96, VtM + (size_t)(b * 8 + h) * 64 * NKEY, Ymla, h * 64, b, qrow0, nkt, sl2_mla, 0.f, smem);
    else
      attn_item<64, true>(Pgqa, 640, h * 64, Pgqa, 640, 512 + (h >> 2) * 64, VtG + (size_t)(b * 2 + (h >> 2)) * 64 * NKEY, Ygqa, h * 64, b, qrow0, nkt, sl2_gqa, c0_gqa, smem);
  }
}

DI int chunk_row0(int b, int m) { return m < 2 ? TL + b * CTXL + m * 128 : b * SEQ + (m - 2) * 128; }
DI int chunk_scan_idx(int dir, int m) { return dir == 0 ? m : (m < 2 ? 1 - m : 35 - m); }
constexpr int LDX = 136;

DI void ssd_cums(const Params& p, int l, int h, int r0, float* sw, float* scum, float* sdt, float& tot_out) {
  const int lane = TIDX & 63, dir = TIDX >> 6;
  const float* DT = (const float*)(p.ws + OFF_DT);
  const float a = -__expf(p.a_log[l * 32 + dir * 16 + h]);
  const int k0 = lane * 2;
  const float d0 = DT[(size_t)(r0 + k0) * 32 + dir * 16 + h], d1 = DT[(size_t)(r0 + k0 + 1) * 32 + dir * 16 + h];
  const float v0 = a * d0, v1 = a * d1;
  float inc = v0 + v1;
#pragma unroll
  for (int off = 1; off < 64; off <<= 1) {
    const float t = __shfl_up(inc, off);
    if (lane >= off) inc += t;
  }
  const float c1 = inc, c0 = inc - v1;
  const float tot = __shfl(inc, 63);
  tot_out = tot;
  if (dir == 0) {
    sw[k0] = __expf(tot - c0) * d0;
    sw[k0 + 1] = __expf(tot - c1) * d1;
    scum[k0] = c0;
    scum[k0 + 1] = c1;
  } else {
    sw[128 + k0] = __expf(c0 - v0) * d0;
    sw[128 + k0 + 1] = __expf(c1 - v1) * d1;
    scum[128 + k0] = tot - c0 + v0;
    scum[128 + k0 + 1] = tot - c1 + v1;
  }
  sdt[dir * 128 + k0] = d0;
  sdt[dir * 128 + k0 + 1] = d1;
}

struct XRegs { uint4 u[4]; };
DI XRegs ssd_load_x(const u16* XBC, int r0, int h) {
  const int lane = TIDX & 63, wid = TIDX >> 6;
  const int k0 = lane * 2;
  XRegs x;
#pragma unroll
  for (int it = 0; it < 2; ++it) {
    const int cn = wid + 4 * it;
    x.u[2 * it] = *(const uint4*)(XBC + (size_t)(r0 + k0) * 1536 + h * 64 + cn * 8);
    x.u[2 * it + 1] = *(const uint4*)(XBC + (size_t)(r0 + k0 + 1) * 1536 + h * 64 + cn * 8);
  }
  return x;
}
DI void ssd_write_xt(const XRegs& x, const float* scale, u16* sXt) {
  const int lane = TIDX & 63, wid = TIDX >> 6;
  const int k0 = lane * 2;
#pragma unroll
  for (int it = 0; it < 2; ++it) {
    const int cn = wid + 4 * it;
    const uint4 u0 = x.u[2 * it], u1 = x.u[2 * it + 1];
#pragma unroll
    for (int dir = 0; dir < 2; ++dir) {
      const float s0 = scale[dir * 128 + k0], s1 = scale[dir * 128 + k0 + 1];
      u16* dst = sXt + dir * 64 * LDX + (cn * 8) * LDX + k0;
      *(unsigned*)(dst + 0 * LDX) = pk2(bflo(u0.x) * s0, bflo(u1.x) * s1);
      *(unsigned*)(dst + 1 * LDX) = pk2(bfhi(u0.x) * s0, bfhi(u1.x) * s1);
      *(unsigned*)(dst + 2 * LDX) = pk2(bflo(u0.y) * s0, bflo(u1.y) * s1);
      *(unsigned*)(dst + 3 * LDX) = pk2(bfhi(u0.y) * s0, bfhi(u1.y) * s1);
      *(unsigned*)(dst + 4 * LDX) = pk2(bflo(u0.z) * s0, bflo(u1.z) * s1);
      *(unsigned*)(dst + 5 * LDX) = pk2(bfhi(u0.z) * s0, bfhi(u1.z) * s1);
      *(unsigned*)(dst + 6 * LDX) = pk2(bflo(u0.w) * s0, bflo(u1.w) * s1);
      *(unsigned*)(dst + 7 * LDX) = pk2(bfhi(u0.w) * s0, bfhi(u1.w) * s1);
    }
  }
}

DI void phase_ssd_states(const Params& p, int l, u16* smem) {
  const u16* XBC = (const u16*)(p.ws + OFF_XBC);
  u16* S = (u16*)(p.ws + OFF_S);
  float* chdec = (float*)(p.ws + OFF_CHDEC);
  u16* sBt = smem;
  u16* sXt = smem + 128 * LDX;
  float* sw = (float*)(smem + 256 * LDX);
  float* scum = sw + 256;
  float* sdt = scum + 256;
  const int tid = TIDX, lane = tid & 63, wid = tid >> 6, lr = lane & 15, lq = lane >> 4;
  for (int it = blockIdx.x; it < NBATCH * NCH * 16; it += gridDim.x) {
    const int h = it & 15, m = (it >> 4) % NCH, b = it / (16 * NCH);
    const int r0 = chunk_row0(b, m), g = h >> 3;
    if (wid < 2) {
      float tot;
      ssd_cums(p, l, h, r0, sw, scum, sdt, tot);
      if (lane == 0) chdec[((wid * 4 + b) * NCH + chunk_scan_idx(wid, m)) * 16 + h] = __expf(tot);
    }
    {
      const int k0 = lane * 2;
#pragma unroll
      for (int i4 = 0; i4 < 4; ++i4) {
        const int cn = wid + 4 * i4;
        const uint4 u0 = *(const uint4*)(XBC + (size_t)(r0 + k0) * 1536 + 1024 + g * 128 + cn * 8);
        const uint4 u1 = *(const uint4*)(XBC + (size_t)(r0 + k0 + 1) * 1536 + 1024 + g * 128 + cn * 8);
        const unsigned a0[4] = {u0.x, u0.y, u0.z, u0.w}, a1[4] = {u1.x, u1.y, u1.z, u1.w};
        u16* dst = sBt + (cn * 8) * LDX + k0;
#pragma unroll
        for (int e = 0; e < 4; ++e) {
          *(unsigned*)(dst + (2 * e) * LDX) = (a0[e] & 0xffffu) | (a1[e] << 16);
          *(unsigned*)(dst + (2 * e + 1) * LDX) = (a0[e] >> 16) | (a1[e] & 0xffff0000u);
        }
      }
    }
    const XRegs xr = ssd_load_x(XBC, r0, h);
    __syncthreads();
    ssd_write_xt(xr, sw, sXt);
    __syncthreads();
    {
      const int dir = wid >> 1, nh = wid & 1;
      f32x4 acc[4][4];
      zero_acc<4>(acc);
      const u16* b_s = sBt + (nh * 64 + lr) * LDX + lq * 8;
      const u16* x_s = sXt + dir * 64 * LDX + lr * LDX + lq * 8;
#pragma unroll
      for (int ks = 0; ks < 4; ++ks) {
        bf16x8 bfv[4], xf[4];
#pragma unroll
        for (int i = 0; i < 4; ++i) {
          bfv[i] = *(const bf16x8*)(b_s + i * 16 * LDX + ks * 32);
          xf[i] = *(const bf16x8*)(x_s + i * 16 * LDX + ks * 32);
        }
#pragma unroll
        for (int pt = 0; pt < 4; ++pt)
#pragma unroll
          for (int nt = 0; nt < 4; ++nt)
            acc[pt][nt] = mma16<true>(bfv[nt], xf[pt], acc[pt][nt]);
      }
      u16* dst = S + ((((size_t)(dir * 4 + b) * NCH + chunk_scan_idx(dir, m)) * 16 + h) * 64) * 128;
#pragma unroll
      for (int pt = 0; pt < 4; ++pt)
#pragma unroll
        for (int nt = 0; nt < 4; ++nt) st_bf4(dst + (size_t)(pt * 16 + lr) * 128 + nh * 64 + nt * 16 + lq * 4, acc[pt][nt]);
    }
    __syncthreads();
  }
}

DI void phase_ssd_scan(const Params& p) {
  u16* S = (u16*)(p.ws + OFF_S);
  const float* chdec = (const float*)(p.ws + OFF_CHDEC);
  const int gtid = blockIdx.x * 256 + TIDX, gn = gridDim.x * 256;
  for (int i = gtid; i < 2 * 4 * 16 * 2048; i += gn) {
    const int e4 = i & 2047, h = (i >> 11) & 15, db = i >> 15;
    float hp[4] = {0.f, 0.f, 0.f, 0.f};
    u16* ptr = S + (((size_t)db * NCH) * 16 + h) * 8192 + e4 * 4;
    const float* dc = chdec + (db * NCH) * 16 + h;
    uint2 u[NCH];
#pragma unroll
    for (int c = 0; c < NCH; ++c) u[c] = *(const uint2*)(ptr + (size_t)c * 16 * 8192);
#pragma unroll
    for (int c = 0; c < NCH; ++c) {
      const float d = dc[c * 16];
      uint2 w;
      w.x = pk2(hp[0], hp[1]);
      w.y = pk2(hp[2], hp[3]);
      *(uint2*)(ptr + (size_t)c * 16 * 8192) = w;
      hp[0] = d * hp[0] + bflo(u[c].x);
      hp[1] = d * hp[1] + bfhi(u[c].x);
      hp[2] = d * hp[2] + bflo(u[c].y);
      hp[3] = d * hp[3] + bfhi(u[c].y);
    }
  }
}

DI void phase_ssd_y(const Params& p, int l, bool with_ctx, u16* smem) {
  const u16* XBC = (const u16*)(p.ws + OFF_XBC);
  const u16* S = (const u16*)(p.ws + OFF_S);
  u16* Yssd = (u16*)(p.ws + OFF_YSSD);
  u16* sB = smem;
  u16* sXt = smem + 128 * LDX;
  float* sw = (float*)(smem + 256 * LDX);
  float* scum = sw + 256;
  float* sdt = scum + 256;
  const int tid = TIDX, lane = tid & 63, wid = tid >> 6, lr = lane & 15, lq = lane >> 4;
  const int m_lo = with_ctx ? 0 : 2;
  const int nm = NCH - m_lo;
  for (int it = blockIdx.x; it < NBATCH * nm * 16; it += gridDim.x) {
    const int h = it & 15, m = m_lo + (it >> 4) % nm, b = it / (16 * nm);
    const int r0 = chunk_row0(b, m), g = h >> 3;
    if (wid < 2) {
      float tot;
      ssd_cums(p, l, h, r0, sw, scum, sdt, tot);
    }
    {
      const u16* hin0 = S + ((((size_t)(0 * 4 + b) * NCH + chunk_scan_idx(0, m)) * 16 + h) * 64) * 128;
      const u16* hin1 = S + ((((size_t)(1 * 4 + b) * NCH + chunk_scan_idx(1, m)) * 16 + h) * 64) * 128;
#pragma unroll
      for (int i = 0; i < 8; ++i) {
        const int id = tid + 256 * i, dir = id >> 10, rem = id & 1023, rr = rem >> 4, cc = rem & 15;
        *(uint4*)(sB + dir * 64 * LDX + rr * LDX + cc * 8) = *(const uint4*)((dir ? hin1 : hin0) + rr * 128 + cc * 8);
      }
    }
    const XRegs xr = ssd_load_x(XBC, r0, h);
    __syncthreads();
    ssd_write_xt(xr, sdt, sXt);
    f32x4 acc0[2][4], acc1[2][4];
#pragma unroll
    for (int qi = 0; qi < 2; ++qi) {
      const int q = wid * 32 + qi * 16 + lr;
      bf16x8 cf[4];
#pragma unroll
      for (int ks = 0; ks < 4; ++ks) cf[ks] = *(const bf16x8*)(XBC + (size_t)(r0 + q) * 1536 + 1280 + g * 128 + ks * 32 + lq * 8);
#pragma unroll
      for (int dir = 0; dir < 2; ++dir) {
        f32x4 t[4];
#pragma unroll
        for (int pt = 0; pt < 4; ++pt) t[pt] = (f32x4){0.f, 0.f, 0.f, 0.f};
#pragma unroll
        for (int ks = 0; ks < 4; ++ks)
#pragma unroll
          for (int pt = 0; pt < 4; ++pt) {
            const bf16x8 hf = *(const bf16x8*)(sB + dir * 64 * LDX + (pt * 16 + lr) * LDX + ks * 32 + lq * 8);
            t[pt] = mma16<true>(hf, cf[ks], t[pt]);
          }
        const float e = __expf(scum[dir * 128 + q]);
#pragma unroll
        for (int pt = 0; pt < 4; ++pt) { if (qi == 0) acc0[dir][pt] = t[pt] * e; else acc1[dir][pt] = t[pt] * e; }
      }
      __builtin_amdgcn_sched_barrier(0);
    }
    __syncthreads();
#pragma unroll
    for (int i = 0; i < 8; ++i) {
      const int id = tid + 256 * i, rr = id >> 4, cc = id & 15;
      *(uint4*)(sB + rr * LDX + cc * 8) = *(const uint4*)(XBC + (size_t)(r0 + rr) * 1536 + 1024 + g * 128 + cc * 8);
    }
    __syncthreads();
    const float dsk = p.d_skip[l * 16 + h];
#pragma unroll 1
    for (int qi = 0; qi < 2; ++qi) {
      const int q = wid * 32 + qi * 16 + lr;
      f32x4 acc[2][4];
#pragma unroll
      for (int dir = 0; dir < 2; ++dir)
#pragma unroll
        for (int pt = 0; pt < 4; ++pt)
#pragma unroll
          for (int j = 0; j < 4; ++j) acc[dir][pt][j] = qi == 0 ? acc0[dir][pt][j] : acc1[dir][pt][j];
      const float cq0 = scum[q], cq1 = scum[128 + q];
      bf16x8 cf[4];
#pragma unroll
      for (int ks = 0; ks < 4; ++ks) cf[ks] = *(const bf16x8*)(XBC + (size_t)(r0 + q) * 1536 + 1280 + g * 128 + ks * 32 + lq * 8);
#pragma unroll 1
      for (int u = 0; u < 4; ++u) {
        f32x4 sc[2];
#pragma unroll
        for (int half = 0; half < 2; ++half) {
          sc[half] = (f32x4){0.f, 0.f, 0.f, 0.f};
#pragma unroll
          for (int ks = 0; ks < 4; ++ks) {
            const bf16x8 bfv = *(const bf16x8*)(sB + ((2 * u + half) * 16 + lr) * LDX + ks * 32 + lq * 8);
            sc[half] = mma16<true>(bfv, cf[ks], sc[half]);
          }
        }
#pragma unroll
        for (int dir = 0; dir < 2; ++dir) {
          const float cq = dir == 0 ? cq0 : cq1;
          union { bf16x8 v; unsigned w[4]; } gp;
#pragma unroll
          for (int half = 0; half < 2; ++half) {
            const int k0 = (2 * u + half) * 16 + lq * 4;
            const f32x4 ck4 = *(const f32x4*)(scum + dir * 128 + k0);
            float gv[4];
#pragma unroll
            for (int j = 0; j < 4; ++j) {
              const int k = k0 + j;
              const bool ok = dir == 0 ? (k <= q) : (k >= q);
              const float arg = ok ? (cq - ck4[j]) * 1.4426950408889634f : -1.0e30f;
              gv[j] = sc[half][j] * __builtin_amdgcn_exp2f(arg);
            }
            gp.w[half * 2] = pk2(gv[0], gv[1]);
            gp.w[half * 2 + 1] = pk2(gv[2], gv[3]);
          }
#pragma unroll
          for (int pt = 0; pt < 4; ++pt) {
            union { bf16x8 v; uint2 hh[2]; } xf;
            const u16* xs = sXt + dir * 64 * LDX + (pt * 16 + lr) * LDX + u * 32 + lq * 4;
            xf.hh[0] = *(const uint2*)(xs);
            xf.hh[1] = *(const uint2*)(xs + 16);
            acc[dir][pt] = mma16<true>(xf.v, gp.v, acc[dir][pt]);
          }
        }
      }
#pragma unroll
      for (int pt = 0; pt < 4; ++pt) {
        const uint2 xu = *(const uint2*)(XBC + (size_t)(r0 + q) * 1536 + h * 64 + pt * 16 + lq * 4);
        f32x4 y = acc[0][pt] + acc[1][pt];
        y[0] += dsk * bflo(xu.x);
        y[1] += dsk * bfhi(xu.x);
        y[2] += dsk * bflo(xu.y);
        y[3] += dsk * bfhi(xu.y);
        st_bf4(Yssd + (size_t)(r0 + q) * 1024 + h * 64 + pt * 16 + lq * 4, y);
      }
    }
    __syncthreads();
  }
}

DI void phase_ssd_finish(const Params& p, int l, int nrows) {
  u16* Yssd = (u16*)(p.ws + OFF_YSSD);
  const u16* Z = (const u16*)(p.ws + OFF_Z);
  const float* g = p.g_ssd + l * 1024;
  const int lane = TIDX & 63;
  const int gw = (blockIdx.x * 256 + TIDX) >> 6, nw = (gridDim.x * 256) >> 6;
  for (int r = gw; r < nrows; r += nw) {
    float v[16];
    float ss = 0.f;
#pragma unroll
    for (int i = 0; i < 2; ++i) {
      const uint4 yu = *(const uint4*)(Yssd + (size_t)r * 1024 + i * 512 + lane * 8);
      const uint4 zu = *(const uint4*)(Z + (size_t)r * 1024 + i * 512 + lane * 8);
      const unsigned ya[4] = {yu.x, yu.y, yu.z, yu.w}, za[4] = {zu.x, zu.y, zu.z, zu.w};
#pragma unroll
      for (int k = 0; k < 4; ++k) {
        const float a = bflo(ya[k]) * siluf(bflo(za[k])), bb = bfhi(ya[k]) * siluf(bfhi(za[k]));
        v[i * 8 + 2 * k] = a;
        v[i * 8 + 2 * k + 1] = bb;
        ss += a * a + bb * bb;
      }
    }
    const float rstd = rsqrtf(wave_sum(ss) * (1.f / 1024.f) + EPS);
#pragma unroll
    for (int i = 0; i < 2; ++i) {
      const f32x4 g0 = *(const f32x4*)(g + i * 512 + lane * 8), g1 = *(const f32x4*)(g + i * 512 + lane * 8 + 4);
      uint4 o;
      o.x = pk2(v[i * 8 + 0] * rstd * g0[0], v[i * 8 + 1] * rstd * g0[1]);
      o.y = pk2(v[i * 8 + 2] * rstd * g0[2], v[i * 8 + 3] * rstd * g0[3]);
      o.z = pk2(v[i * 8 + 4] * rstd * g1[0], v[i * 8 + 5] * rstd * g1[1]);
      o.w = pk2(v[i * 8 + 6] * rstd * g1[2], v[i * 8 + 7] * rstd * g1[3]);
      *(uint4*)(Yssd + (size_t)r * 1024 + i * 512 + lane * 8) = o;
    }
  }
}

DI void phase_merge(const Params& p, int l, int nrows, const float* srcL, const float* srcC, u16* smem) {
  const u16* H = (const u16*)(p.ws + OFF_H2);
  const u16* W0 = (const u16*)(p.ws + OFF_W0);
  const float* modl = (const float*)(p.ws + OFF_MODV) + (size_t)l * 5 * 6144;
  const float* bg = p.b_gate + l * 3072;
  float* XC = (float*)(p.ws + OFF_XC);
  const int tid = TIDX, lane = tid & 63, wid = tid >> 6, wm = wid >> 1, wn = wid & 1, lr = lane & 15, lq = lane >> 4;
  const int MT = nrows / 128;
  XCD_TILE_LOOP(MT, 8) {
    int mt, nt;
    tile_xcd(j_, blockIdx.x & 7, MT >> 3, 8, mt, nt);
    const int n0 = nt * 128;
#pragma unroll 1
    for (int br = 0; br < 3; ++br) {
      const u16* Ybr = (const u16*)(p.ws + (br == 0 ? OFF_YMLA : (br == 1 ? OFF_YSSD : OFF_YGQA)));
      const int ldyb = br == 1 ? 1024 : 512, koffb = br == 0 ? 0 : (br == 1 ? 512 : 1536);
      f32x4 gt[4][4];
      zero_acc<4>(gt);
      gemm_core<4>(H + (size_t)mt * 128 * 1024, 1024, W0 + (size_t)(br * 1024 + n0) * 1024, 1024, 1024, gt, smem);
      uint2 gp[4][4];
#pragma unroll
      for (int ni = 0; ni < 4; ++ni) {
        const f32x4 bv = *(const f32x4*)(bg + br * 1024 + n0 + wn * 64 + ni * 16 + lq * 4);
#pragma unroll
        for (int mi = 0; mi < 4; ++mi) {
          gp[mi][ni].x = pk2(sigmf(gt[mi][ni][0] + bv[0]), sigmf(gt[mi][ni][1] + bv[1]));
          gp[mi][ni].y = pk2(sigmf(gt[mi][ni][2] + bv[2]), sigmf(gt[mi][ni][3] + bv[3]));
          asm volatile("" : "+v"(gp[mi][ni].x), "+v"(gp[mi][ni].y));
        }
      }
      f32x4 ya[4][4];
      zero_acc<4>(ya);
      gemm_core<4>(Ybr + (size_t)mt * 128 * ldyb, ldyb, W0 + W0_OUT + (size_t)n0 * 2048 + koffb, 2048, ldyb, ya, smem);
#pragma unroll
      for (int mi = 0; mi < 4; ++mi) {
        const int row = mt * 128 + wm * 64 + mi * 16 + lr;
        const float* src = row < TL ? srcL + (size_t)row * D : srcC + (size_t)(row - TL) * D;
        float* dst = row < TL ? p.out + (size_t)row * D : XC + (size_t)(row - TL) * D;
        const float* g1 = modl + row_mod(row) * 6144 + 2048;
#pragma unroll
        for (int ni = 0; ni < 4; ++ni) {
          const int col = n0 + wn * 64 + ni * 16 + lq * 4;
          const f32x4 gv = *(const f32x4*)(g1 + col);
          f32x4 base;
          if (br == 0) base = ALPHA * *(const f32x4*)(src + col);
          else base = *(const f32x4*)(dst + col);
          f32x4 gf;
          gf[0] = bflo(gp[mi][ni].x); gf[1] = bfhi(gp[mi][ni].x); gf[2] = bflo(gp[mi][ni].y); gf[3] = bfhi(gp[mi][ni].y);
          *(f32x4*)(dst + col) = base + gv * (gf * ya[mi][ni]);
        }
        __builtin_amdgcn_sched_barrier(0);
      }
    }
  }
}

DI void phase_ffn_in(const Params& p, int nrows, u16* smem) {
  const u16* H = (const u16*)(p.ws + OFF_H2);
  const u16* W0 = (const u16*)(p.ws + OFF_W0);
  u16* ACT = (u16*)(p.ws + OFF_ACT);
  const int tid = TIDX, lane = tid & 63, wid = tid >> 6, wm = wid >> 1, wn = wid & 1, lr = lane & 15, lq = lane >> 4;
  const int MT = nrows / 128;
  XCD_TILE_LOOP(MT, 44) {
    int mt, nt;
    tile_xcd(j_, blockIdx.x & 7, MT >> 3, 44, mt, nt);
    f32x4 acc[4][4];
    zero_acc<4>(acc);
    gemm_core<4, true>(H + (size_t)mt * 128 * 1024, 1024, W0 + (size_t)nt * 128 * 1024, 1024, 1024, acc, smem);
#pragma unroll
    for (int mi = 0; mi < 4; ++mi) {
      const int row = mt * 128 + wm * 64 + mi * 16 + lr;
#pragma unroll
      for (int pr = 0; pr < 2; ++pr) {
        const int q = (nt * 128 + wn * 64 + pr * 32) >> 5;
        f32x4 v;
#pragma unroll
        for (int j = 0; j < 4; ++j) v[j] = siluf(acc[mi][2 * pr][j]) * acc[mi][2 * pr + 1][j];
        st_h4(ACT + (size_t)row * FFN_H + q * 16 + lq * 4, v);
      }
    }
  }
}

DI void phase_ffn_out(const Params& p, int l, int nrows, u16* smem) {
  const u16* ACT = (const u16*)(p.ws + OFF_ACT);
  const u16* W1 = (const u16*)(p.ws + OFF_W1);
  const float* modl = (const float*)(p.ws + OFF_MODV) + (size_t)l * 5 * 6144;
  float* XC = (float*)(p.ws + OFF_XC);
  const int tid = TIDX, lane = tid & 63, wid = tid >> 6, wm = wid >> 1, wn = wid & 1, lr = lane & 15, lq = lane >> 4;
  const int MT = nrows / 128;
  XCD_TILE_LOOP(MT, 8) {
    int mt, nt;
    tile_xcd(j_, blockIdx.x & 7, MT >> 3, 8, mt, nt);
    f32x4 acc[4][4];
    zero_acc<4>(acc);
    gemm_core<4, true>(ACT + (size_t)mt * 128 * FFN_H, FFN_H, W1 + (size_t)nt * 128 * FFN_H, FFN_H, FFN_H, acc, smem);
#pragma unroll
    for (int mi = 0; mi < 4; ++mi) {
      const int row = mt * 128 + wm * 64 + mi * 16 + lr;
      float* xp = row < TL ? p.out + (size_t)row * D : XC + (size_t)(row - TL) * D;
      const float* g2 = modl + row_mod(row) * 6144 + 5120;
#pragma unroll
      for (int ni = 0; ni < 4; ++ni) {
        const int col = nt * 128 + wn * 64 + ni * 16 + lq * 4;
        const f32x4 xv = *(const f32x4*)(xp + col), gv = *(const f32x4*)(g2 + col);
        *(f32x4*)(xp + col) = ALPHA * xv + gv * acc[mi][ni];
      }
    }
  }
}

#define XB_TMO      128
#define XB_XCNT(j)  (256  + 64 * (j))
#define XB_XSUB(j)  (1280 + 64 * (j))
#define XB_XGEN(j)  (2304 + 64 * (j))
#define XB_TOP      3328
#define XB_TOPGEN   3392
#define XCD_BAR_WORDS 3456
#define XB_SPIN_CAP (1u << 20)
#define LAS __attribute__((address_space(3)))
DI unsigned xb_ld(unsigned* p) { return __hip_atomic_load(p, __ATOMIC_RELAXED, __HIP_MEMORY_SCOPE_AGENT); }
DI unsigned xb_add(unsigned* p, unsigned v) { return __hip_atomic_fetch_add(p, v, __ATOMIC_RELAXED, __HIP_MEMORY_SCOPE_AGENT); }
DI unsigned xb_xcc_id() { return (unsigned)__builtin_amdgcn_s_getreg((3 << 11) | 20) & 0xFu; }
#define XB_SPIN(cond, bar) do { unsigned _sp = 0; while (cond) { __builtin_amdgcn_s_sleep(1); \
    if ((++_sp & 255u) == 0u) { if (xb_ld(&(bar)[XB_TMO])) break; if (_sp > XB_SPIN_CAP) { atomicAdd(&(bar)[XB_TMO], 1u); break; } } } } while (0)
struct XcdBarrier { unsigned* bar; unsigned x; volatile LAS unsigned* st; };
DI XcdBarrier xcd_barrier_post(unsigned* bar, volatile LAS unsigned* st) {
  XcdBarrier b; b.bar = bar; b.x = xb_xcc_id(); b.st = st;
  if (threadIdx.x == 0) (void)xb_add(&bar[XB_XCNT(b.x)], 1u);
  return b;
}
DI void xcd_barrier_complete(unsigned* bar, unsigned x, unsigned& nloc, unsigned& nx) {
  const unsigned G = gridDim.x * gridDim.y * gridDim.z;
  unsigned sum, cnt, mine, sp = 0u;
  for (;;) {
    sum = 0u; cnt = 0u; mine = 0u;
#pragma unroll
    for (unsigned j = 0; j < 16; ++j) { const unsigned c = xb_ld(&bar[XB_XCNT(j)]); sum += c; cnt += (c > 0u) ? 1u : 0u; mine = (j == x) ? c : mine; }
    if (sum == G) break;
    __builtin_amdgcn_s_sleep(1);
    if ((++sp & 255u) == 0u) { if (xb_ld(&bar[XB_TMO])) break; if (sp > XB_SPIN_CAP) { atomicAdd(&bar[XB_TMO], 1u); break; } }
  }
  nloc = mine > 0u ? mine : 1u; nx = cnt > 0u ? cnt : 1u;
}
DI void xcd_barrier(const XcdBarrier& b) {
  asm volatile("s_waitcnt vmcnt(0)" ::: "memory");
  __syncthreads();
  if (threadIdx.x == 0) {
    unsigned* bar = b.bar;
    __builtin_amdgcn_s_waitcnt(0);
    unsigned nloc = b.st[0], nx = b.st[1];
    if (nloc == 0u) { xcd_barrier_complete(bar, b.x, nloc, nx); b.st[0] = nloc; b.st[1] = nx; }
    const unsigned old = xb_add(&bar[XB_XSUB(b.x)], 1u);
    const unsigned gen = old / nloc;
    if (old + 1u == (gen + 1u) * nloc) {
      __builtin_amdgcn_fence(__ATOMIC_RELEASE, "agent");
      asm volatile("s_waitcnt vmcnt(0)" ::: "memory");
      const unsigned og = xb_add(&bar[XB_TOP], 1u);
      const unsigned tg = og / nx;
      if (og + 1u == (tg + 1u) * nx) xb_add(&bar[XB_TOPGEN], 1u);
      else XB_SPIN(xb_ld(&bar[XB_TOPGEN]) == tg, bar);
      __builtin_amdgcn_fence(__ATOMIC_ACQUIRE, "agent");
      xb_add(&bar[XB_XGEN(b.x)], 1u);
      asm volatile("s_waitcnt vmcnt(0)" ::: "memory");
    } else {
      XB_SPIN(xb_ld(&bar[XB_XGEN(b.x)]) == gen, bar);
      __builtin_amdgcn_fence(__ATOMIC_ACQUIRE, "agent");
      asm volatile("s_waitcnt vmcnt(0)" ::: "memory");
    }
  }
  __syncthreads();
}

constexpr int NPHASE = 2 + 13 * 2;

__global__ void __launch_bounds__(256, 2) fwd_megakernel(Params p) {
  __shared__ __attribute__((aligned(16))) unsigned char smem_raw[SMEM_BYTES];
  u16* smem = (u16*)smem_raw;
  float* smf = (float*)smem_raw;
  cg::grid_group grid = cg::this_grid();
  __shared__ uint4 xb_words;
  if (threadIdx.x == 0) xb_words = make_uint4(0u, 0u, 0u, 0u);
  __syncthreads();
  XcdBarrier xb = xcd_barrier_post((unsigned*)(p.ws + OFF_BAR), (volatile LAS unsigned*)&xb_words);
  if (p.ph0 < 0) grid.sync();
  const float* modv = (const float*)(p.ws + OFF_MODV);
  float* XC = (float*)(p.ws + OFF_XC);
  for (int ph = p.ph0; ph < p.ph1; ++ph) {
    if (ph == 0) {
      phase_prologue(p, smf);
      cvt_inproj_set(p, 0, smf);
    } else if (ph == 1) {
      ln_rows<0>(p, T, p.x, p.ctx, nullptr, nullptr, nullptr, nullptr, modv, 0, 1024, (u16*)(p.ws + OFF_H), true);
    } else {
      const int l = (ph - 2) / 13, s = (ph - 2) % 13;
      const bool with_ctx = (l == 0);
      const int nrows = with_ctx ? T : TL;
      const float* modl = modv + (size_t)l * 5 * 6144;
      const float* srcL = (l == 0) ? p.x : p.out;
      const float* srcC = (l == 0) ? p.ctx : XC;
      switch (s) {
        case 0: phase_inproj(p, l, smem); break;
        case 1: phase_c1(p, l); break;
        case 2: phase_c2(p, l, smem); break;
        case 3: phase_attn(p, l, with_ctx, smem); break;
        case 4: phase_ssd_states(p, l, smem); break;
        case 5: phase_ssd_scan(p); cvt_merge_set(p, l, smf); break;
        case 6: phase_ssd_y(p, l, with_ctx, smem); break;
        case 7:
          phase_ssd_finish(p, l, nrows);
          ln_rows<0>(p, nrows, srcL, srcC, nullptr, nullptr, nullptr, nullptr, modl, 0, 1024, (u16*)(p.ws + OFF_H2), true);
          break;
        case 8: phase_merge(p, l, nrows, srcL, srcC, smem); break;
        case 9:
          ln_rows<1>(p, nrows, p.out, XC, p.out, XC, p.ln1_g + l * D, p.ln1_b + l * D, modl, 3072, 4096, (u16*)(p.ws + OFF_H2), true, true);
          cvt_ffn_set(p, l, smf);
          break;
        case 10: phase_ffn_in(p, nrows, smem); break;
        case 11: phase_ffn_out(p, l, nrows, smem); break;
        case 12:
          if (l == 0) {
            ln_rows<1>(p, nrows, p.out, XC, p.out, XC, p.ln2_g + l * D, p.ln2_b + l * D, modv + (size_t)5 * 6144, 0, 1024, (u16*)(p.ws + OFF_H), true);
            cvt_inproj_set(p, 1, smf);
          } else {
            ln_rows<1>(p, nrows, p.out, XC, p.out, XC, p.ln2_g + l * D, p.ln2_b + l * D, modl, 0, 1024, nullptr, false);
          }
          break;
      }
    }
    if (ph + 1 < p.ph1) xcd_barrier(xb);
  }
#ifdef DBG_N
  grid.sync();
  {
    const u16* w16 = (const u16*)p.ws;
    const size_t n16 = WS_END / 2;
    const int gtid = blockIdx.x * 256 + TIDX, gn = gridDim.x * 256;
    for (int i = gtid; i < TL * D; i += gn) {
      unsigned s = 0;
      for (int j = 0; j < 8; ++j) {
        const size_t a = (size_t)i + (size_t)j * (size_t)(TL * D);
        if (a < n16) s += w16[a] * (unsigned)(j + 1);
      }
      p.out[i] = (float)(s & 0xFFFFFu);
    }
  }
#endif
}

extern "C" void kernel_launch(void* const* d_in, const int* in_sizes, int n_in, void* d_out, int out_size, void* d_ws,
                              size_t ws_size, hipStream_t stream) {
  static int grid_blocks = 0;
  if (!grid_blocks) {
    int dev = 0, cus = 0, per_cu = 0;
    (void)hipGetDevice(&dev);
    (void)hipDeviceGetAttribute(&cus, hipDeviceAttributeMultiprocessorCount, dev);
    (void)hipOccupancyMaxActiveBlocksPerMultiprocessor(&per_cu, fwd_megakernel, 256, 0);
    if (per_cu > 2) per_cu = 2;
    if (per_cu < 1) per_cu = 1;
    grid_blocks = cus * per_cu;
  }
  if (n_in != 27 || ws_size < WS_TOTAL || out_size != TL * D) {
    fprintf(stderr, "kernel_launch: unexpected shapes (n_in %d, out %d, ws %zu < %zu)\n", n_in, out_size, ws_size, (size_t)WS_END);
    return;
  }
  Params p{};
  const float** pp = (const float**)&p;
  for (int i = 0; i < 27; ++i) pp[i] = (const float*)d_in[i];
  p.out = (float*)d_out;
  p.ws = (char*)d_ws;
  p.ph0 = 0;
#ifdef DBG_N
  p.ph1 = DBG_N;
#else
  p.ph1 = NPHASE;
#endif
  (void)hipMemsetAsync((char*)d_ws + OFF_BAR, 0, XCD_BAR_WORDS * 4, stream);
  void* args[] = {&p};
  hipError_t e = hipLaunchCooperativeKernel((void*)fwd_megakernel, dim3(grid_blocks), dim3(256), args, 0, stream);
  if (e != hipSuccess) fprintf(stderr, "cooperative launch failed: %s (grid %d)\n", hipGetErrorString(e), grid_blocks);
}
```

```cpp
#include <hip/hip_runtime.h>
#include <hip/hip_cooperative_groups.h>
#include <cstdio>
namespace cg = cooperative_groups;

typedef unsigned short u16;
typedef __attribute__((ext_vector_type(8))) short bf16x8;
typedef __attribute__((ext_vector_type(4))) float f32x4;
#define DI __device__ __forceinline__

constexpr int D = 1024, NBATCH = 4, SEQ = 4096, CTXL = 256;
constexpr int TL = NBATCH * SEQ, TC = NBATCH * CTXL, T = TL + TC;
constexpr int NKEY = CTXL + SEQ;
constexpr int NCH = 34;
constexpr int IN_W = 7104, FFN_H = 2816;
constexpr int WINP = 4224;
constexpr float EPS = 1e-6f;
constexpr float ALPHA = 1.41421356237f;

constexpr size_t OFF_MODV = 0;
constexpr size_t OFF_COSM = OFF_MODV + 2 * 5 * 6144 * 4;
constexpr size_t OFF_SINM = OFF_COSM + 4096 * 16 * 4;
constexpr size_t OFF_COSG = OFF_SINM + 4096 * 16 * 4;
constexpr size_t OFF_SING = OFF_COSG + 4096 * 32 * 4;
constexpr size_t OFF_STATS = OFF_SING + 4096 * 32 * 4;
constexpr size_t OFF_CHDEC = OFF_STATS + (size_t)T * 2 * 4;
constexpr size_t OFF_XC = OFF_CHDEC + 2 * 4 * 34 * 16 * 4;
constexpr size_t OFF_W0 = OFF_XC + (size_t)TC * D * 4;
constexpr size_t OFF_W1 = OFF_W0 + (size_t)5632 * 1024 * 2;
constexpr size_t OFF_VTG = OFF_W1 + (size_t)1024 * 2816 * 2;
constexpr size_t OFF_R0 = OFF_VTG + (size_t)4 * 2 * 64 * NKEY * 2;
constexpr size_t SZ_T1024 = (size_t)T * 1024 * 2;
constexpr size_t SZ_XBC = (size_t)T * 1536 * 2;
constexpr size_t OFF_R1 = OFF_R0 + SZ_T1024 + SZ_XBC;
constexpr size_t OFF_R2 = OFF_R1 + SZ_T1024;
constexpr size_t OFF_R3 = OFF_R2 + SZ_XBC;
constexpr size_t OFF_R4 = OFF_R3 + (size_t)T * 32 * 4;
constexpr size_t OFF_BAR = OFF_R4 + SZ_XBC;
constexpr size_t WS_END = OFF_R4 + SZ_XBC;
constexpr size_t WS_TOTAL = OFF_BAR + 16384;
constexpr size_t OFF_H = OFF_R0;
constexpr size_t OFF_XR = OFF_R0 + SZ_T1024;
constexpr size_t OFF_QM = OFF_R0;
constexpr size_t OFF_KM = OFF_QM + (size_t)T * 768 * 2;
constexpr size_t OFF_VTM = OFF_KM + (size_t)T * 768 * 2;
constexpr size_t OFF_YMLA = OFF_VTM + (size_t)T * 512 * 2;
constexpr size_t OFF_S = OFF_R0;
constexpr size_t OFF_ACT = OFF_R0;
constexpr size_t OFF_Z = OFF_R1;
constexpr size_t OFF_XBC = OFF_R2;
constexpr size_t OFF_H2 = OFF_R2;
constexpr size_t OFF_DT = OFF_R3;
constexpr size_t OFF_PGQA = OFF_R4;
constexpr size_t OFF_PMLA = OFF_R4 + (size_t)T * 640 * 2;
constexpr size_t OFF_YGQA = OFF_R4 + SZ_T1024;
constexpr size_t OFF_YSSD = OFF_R4;
static_assert(OFF_YMLA + (size_t)T * 512 * 2 == OFF_R1, "R0 layout");
static_assert(OFF_PMLA + (size_t)T * 672 * 2 <= WS_END, "R4 layout");
static_assert(OFF_YGQA + (size_t)T * 512 * 2 == WS_END, "R4 layout");
static_assert((size_t)2 * 4 * 34 * 16 * 64 * 128 * 2 <= (size_t)T * (768 + 768 + 512) * 2, "S fits");
static_assert(OFF_ACT + (size_t)T * 2816 * 2 <= OFF_R2, "ACT fits");
constexpr size_t W0_UQ = (size_t)WINP * 1024;
constexpr size_t W0_UKV = W0_UQ + (size_t)768 * 384;
constexpr size_t W0_OUT = (size_t)3072 * 1024;

constexpr int SMEM_BYTES = 73728;

struct Params {
  const float *x, *c, *ctx, *c_ctx, *w_mod, *b_mod, *w_in, *b_gate, *w_uq, *g_q_mla, *w_ukv, *g_kv_mla, *conv_w,
      *conv_b, *a_log, *dt_bias, *d_skip, *g_ssd, *g_q_gqa, *g_k_gqa, *w_out, *ln1_g, *ln1_b, *w_ffn_in, *w_ffn_out,
      *ln2_g, *ln2_b;
  float* out;
  char* ws;
  int ph0, ph1;
};

DI int threadIdx_x_raw() { return (int)__builtin_amdgcn_workitem_id_x(); }
DI int opaque_tid() { int t = threadIdx_x_raw(); asm volatile("" : "+v"(t)); return t; }
#define TIDX opaque_tid()
typedef _Float16 f16x2_t __attribute__((ext_vector_type(2)));
typedef _Float16 f16x8_t __attribute__((ext_vector_type(8)));
DI float bflo(unsigned w) { return (float)__builtin_bit_cast(f16x2_t, w)[0]; }
DI float bfhi(unsigned w) { return (float)__builtin_bit_cast(f16x2_t, w)[1]; }
DI float bf2f(u16 h) { return bflo((unsigned)h); }
typedef __bf16 bf16x2_t __attribute__((ext_vector_type(2)));
typedef float f32x2_t __attribute__((ext_vector_type(2)));
DI unsigned pk2(float lo, float hi) {
  f32x2_t f = {lo, hi};
  f16x2_t b = __builtin_convertvector(f, f16x2_t);
  return __builtin_bit_cast(unsigned, b);
}
DI u16 f2bf(float f) { return (u16)(pk2(f, 0.f) & 0xffffu); }
DI unsigned pkh2(float lo, float hi) {
  f32x2_t f = {lo, hi};
  f16x2_t b = __builtin_convertvector(f, f16x2_t);
  return __builtin_bit_cast(unsigned, b);
}
DI u16 f2h(float f) { return (u16)(pkh2(f, 0.f) & 0xffffu); }
DI float siluf(float x) { return x / (1.f + __expf(-x)); }
DI float sigmf(float x) { return 1.f / (1.f + __expf(-x)); }
DI void st_bf4(u16* p, f32x4 v) {
  uint2 u;
  u.x = pk2(v[0], v[1]);
  u.y = pk2(v[2], v[3]);
  *(uint2*)p = u;
}
DI void st_h4(u16* p, f32x4 v) {
  uint2 u;
  u.x = pkh2(v[0], v[1]);
  u.y = pkh2(v[2], v[3]);
  *(uint2*)p = u;
}
template <bool F16>
DI f32x4 mma16(bf16x8 a, bf16x8 b, f32x4 c) {
  return __builtin_amdgcn_mfma_f32_16x16x32_f16(__builtin_bit_cast(f16x8_t, a), __builtin_bit_cast(f16x8_t, b), c, 0, 0, 0);
}
DI int row_mod(int r) { return r < TL ? (r >> 12) : 4; }
DI int row_batch(int r) { return r < TL ? (r >> 12) : ((r - TL) >> 8); }
DI int row_key(int r) { return r < TL ? CTXL + (r & 4095) : ((r - TL) & 255); }
DI float quad_max(float v) {
  auto r = __builtin_amdgcn_permlane16_swap(__float_as_uint(v), __float_as_uint(v), false, false);
  v = fmaxf(__uint_as_float(r[0]), __uint_as_float(r[1]));
  auto s = __builtin_amdgcn_permlane32_swap(__float_as_uint(v), __float_as_uint(v), false, false);
  return fmaxf(__uint_as_float(s[0]), __uint_as_float(s[1]));
}
DI float quad_sum(float v) {
  auto r = __builtin_amdgcn_permlane16_swap(__float_as_uint(v), __float_as_uint(v), false, false);
  v = __uint_as_float(r[0]) + __uint_as_float(r[1]);
  auto s = __builtin_amdgcn_permlane32_swap(__float_as_uint(v), __float_as_uint(v), false, false);
  return __uint_as_float(s[0]) + __uint_as_float(s[1]);
}
DI float wave_sum(float v) {
#pragma unroll
  for (int o = 32; o > 0; o >>= 1) v += __shfl_xor(v, o);
  return v;
}

#define GAS __attribute__((address_space(1)))
#define LAS3 __attribute__((address_space(3)))
template <int NI, bool F16 = false>
DI void gemm_core(const u16* __restrict__ A, int lda, const u16* __restrict__ B, int ldb, int K, f32x4 (&acc)[4][NI],
                  u16* smem) {
  constexpr int BN = 32 * NI;
  constexpr int NBL = BN / 32;
  char* sA = (char*)smem;
  char* sB = sA + 2 * 16384;
  const int tid = TIDX, lane = tid & 63, wid = tid >> 6, wm = wid >> 1, wn = wid & 1;
  const int lr = lane & 15, lq = lane >> 4;
  const int r8 = tid >> 3, gc = (tid & 7) ^ (r8 & 7);
  const u16* Ap = A + (size_t)r8 * lda + gc * 8;
  const u16* Bp = B + (size_t)r8 * ldb + gc * 8;
  const int nk = K >> 6;
#define GEMM_ISSUE(KT, BUF)                                                                                         \
  {                                                                                                                 \
    const int ko_ = (KT) * 64;                                                                                      \
    _Pragma("unroll") for (int i = 0; i < 4; ++i)                                                                   \
        __builtin_amdgcn_global_load_lds((const GAS unsigned*)(Ap + (size_t)(32 * i) * lda + ko_),                  \
                                         (LAS3 unsigned*)(sA + (BUF) * 16384 + i * 4096 + tid * 16), 16, 0, 0);     \
    _Pragma("unroll") for (int i = 0; i < NBL; ++i)                                                                 \
        __builtin_amdgcn_global_load_lds((const GAS unsigned*)(Bp + (size_t)(32 * i) * ldb + ko_),                  \
                                         (LAS3 unsigned*)(sB + (BUF) * (BN * 128) + i * 4096 + tid * 16), 16, 0, 0); \
  }
  GEMM_ISSUE(0, 0)
  asm volatile("s_waitcnt vmcnt(0)" ::: "memory");
  __builtin_amdgcn_s_barrier();
  const int x0 = ((0 + lq) ^ (lr & 7)) << 4, x1 = ((4 + lq) ^ (lr & 7)) << 4;
  const unsigned la = (unsigned)(size_t)((LAS3 char*)(sA + (wm * 64 + lr) * 128));
  const unsigned lb = (unsigned)(size_t)((LAS3 char*)(sB + (wn * 16 * NI + lr) * 128));
  const unsigned la0 = la + x0, la1 = la + x1, lb0 = lb + x0, lb1 = lb + x1;
#define LDSR(dst, addr, off) asm volatile("ds_read_b128 %0, %1 offset:%2" : "=v"(dst) : "v"(addr), "n"(off))
#define GEMM_HALF(BUF, LA, LB)                                                                             \
  {                                                                                                        \
    bf16x8 a0[4], b0[NI];                                                                                  \
    LDSR(a0[0], LA, (BUF) * 16384 + 0 * 2048); LDSR(a0[1], LA, (BUF) * 16384 + 1 * 2048);                  \
    LDSR(a0[2], LA, (BUF) * 16384 + 2 * 2048); LDSR(a0[3], LA, (BUF) * 16384 + 3 * 2048);                  \
    LDSR(b0[0], LB, (BUF) * (BN * 128) + 0 * 2048); LDSR(b0[1], LB, (BUF) * (BN * 128) + 1 * 2048);        \
    if (NI == 4) { LDSR(b0[NI - 2], LB, (BUF) * (BN * 128) + 2 * 2048); LDSR(b0[NI - 1], LB, (BUF) * (BN * 128) + 3 * 2048); } \
    if (NI == 4) asm volatile("s_waitcnt lgkmcnt(0)" : "+v"(a0[0]), "+v"(a0[1]), "+v"(a0[2]), "+v"(a0[3]), "+v"(b0[0]), "+v"(b0[1]), "+v"(b0[NI - 2]), "+v"(b0[NI - 1])); \
    else asm volatile("s_waitcnt lgkmcnt(0)" : "+v"(a0[0]), "+v"(a0[1]), "+v"(a0[2]), "+v"(a0[3]), "+v"(b0[0]), "+v"(b0[1])); \
    _Pragma("unroll") for (int mi = 0; mi < 4; ++mi)                                                       \
        _Pragma("unroll") for (int ni = 0; ni < NI; ++ni)                                                  \
            acc[mi][ni] = mma16<F16>(b0[ni], a0[mi], acc[mi][ni]);                                         \
  }
#define GEMM_COMPUTE(BUF) GEMM_HALF(BUF, la0, lb0) GEMM_HALF(BUF, la1, lb1)
  for (int kt = 0; kt < nk; kt += 2) {
    GEMM_ISSUE(kt + 1, 1)
    GEMM_COMPUTE(0)
    asm volatile("s_waitcnt vmcnt(0)" ::: "memory");
    __builtin_amdgcn_s_barrier();
    if (kt + 2 < nk) GEMM_ISSUE(kt + 2, 0)
    GEMM_COMPUTE(1)
    asm volatile("s_waitcnt vmcnt(0)" ::: "memory");
    __builtin_amdgcn_s_barrier();
  }
#undef GEMM_COMPUTE
#undef GEMM_HALF
#undef LDSR
#undef GEMM_ISSUE
}

template <int NI>
DI void zero_acc(f32x4 (&acc)[4][NI]) {
#pragma unroll
  for (int i = 0; i < 4; ++i)
#pragma unroll
    for (int j = 0; j < NI; ++j) acc[i][j] = (f32x4){0.f, 0.f, 0.f, 0.f};
}

DI void tile_xcd(int j, int x, int mc, int NT, int& mt, int& nt) {
  const int h0 = (mc + 3) >> 2;
  const int per = h0 * NT, blk = j / per, rem = j - blk * per;
  const int hb = (mc - blk * h0) < h0 ? (mc - blk * h0) : h0;
  const int ml = blk * h0 + rem % hb;
  nt = rem / hb;
  mt = ml * 8 + x;
}
#define XCD_TILE_LOOP(MT_, NT_) for (int j_ = blockIdx.x >> 3; j_ < ((MT_) >> 3) * (NT_); j_ += gridDim.x >> 3)
DI void tile_mn(int t, int MT, int NT, int& mt, int& nt) {
  const int per = 16 * NT;
  const int grp = t / per, rem = t - grp * per;
  const int gsz = (MT - grp * 16) < 16 ? (MT - grp * 16) : 16;
  mt = grp * 16 + rem % gsz;
  nt = rem / gsz;
}

struct MapIdent { int base; DI int operator()(int r) const { return base + r; } };
struct MapInproj {
  DI int operator()(int r) const {
    if (r < 768) return r < 672 ? r : -1;
    if (r < 1792) return 672 + (r - 768);
    if (r < 3328) return 1696 + (r - 1792);
    if (r < 3456) return (r - 3328) < 32 ? 3232 + (r - 3328) : -1;
    return 3264 + (r - 3456);
  }
};
struct MapFfnIn {
  DI int operator()(int r) const {
    const int q = r >> 5, s = r & 31;
    return s < 16 ? 16 * q + s : FFN_H + 16 * q + (s - 16);
  }
};
template <class Map, bool F16 = false>
DI void cvt_tile(const float* __restrict__ src, int ldsrc, u16* __restrict__ dst, int K, int r0, int k0,
                 const float* kscale, Map map, float* tile) {
  const int tid = TIDX;
  {
    const int rl = tid & 63;
    const int sc = map(r0 + rl);
#pragma unroll 4
    for (int i = 0; i < 16; ++i) {
      const int kl = (tid >> 6) + 4 * i;
      tile[kl * 65 + rl] = sc >= 0 ? src[(size_t)(k0 + kl) * ldsrc + sc] : 0.f;
    }
  }
  __syncthreads();
  {
    const int kl = tid & 63;
    const float s = kscale ? kscale[k0 + kl] : 1.f;
#pragma unroll 4
    for (int i = 0; i < 16; ++i) {
      const int rl = (tid >> 6) + 4 * i;
      dst[(size_t)(r0 + rl) * K + k0 + kl] = F16 ? f2h(tile[kl * 65 + rl] * s) : f2bf(tile[kl * 65 + rl] * s);
    }
  }
  __syncthreads();
}
DI void cvt_inproj_set(const Params& p, int l, float* tile) {
  u16* W0 = (u16*)(p.ws + OFF_W0);
  constexpr int N1 = (WINP / 64) * 16, N2 = (768 / 64) * (384 / 64), N3 = (1024 / 64) * (256 / 64);
  for (int it = blockIdx.x; it < N1 + N2 + N3; it += gridDim.x) {
    if (it < N1) {
      cvt_tile(p.w_in + (size_t)l * 1024 * IN_W, IN_W, W0, 1024, (it >> 4) * 64, (it & 15) * 64, nullptr, MapInproj(), tile);
    } else if (it < N1 + N2) {
      const int j = it - N1;
      cvt_tile(p.w_uq + (size_t)l * 384 * 768, 768, W0 + W0_UQ, 384, (j / 6) * 64, (j % 6) * 64, p.g_q_mla + l * 384, MapIdent{0}, tile);
    } else {
      const int j = it - N1 - N2;
      cvt_tile(p.w_ukv + (size_t)l * 256 * 1024, 1024, W0 + W0_UKV, 256, (j >> 2) * 64, (j & 3) * 64, p.g_kv_mla + l * 256, MapIdent{0}, tile);
    }
  }
}
DI void cvt_merge_set(const Params& p, int l, float* tile) {
  u16* W0 = (u16*)(p.ws + OFF_W0);
  constexpr int N1 = (3072 / 64) * 16, N2 = (1024 / 64) * (2048 / 64);
  for (int it = blockIdx.x; it < N1 + N2; it += gridDim.x) {
    if (it < N1) {
      cvt_tile(p.w_in + (size_t)l * 1024 * IN_W, IN_W, W0, 1024, (it >> 4) * 64, (it & 15) * 64, nullptr, MapIdent{4032}, tile);
    } else {
      const int j = it - N1;
      cvt_tile(p.w_out + (size_t)l * 2048 * 1024, 1024, W0 + W0_OUT, 2048, (j >> 5) * 64, (j & 31) * 64, nullptr, MapIdent{0}, tile);
    }
  }
}
DI void cvt_ffn_set(const Params& p, int l, float* tile) {
  u16* W0 = (u16*)(p.ws + OFF_W0);
  u16* W1 = (u16*)(p.ws + OFF_W1);
  constexpr int N1 = (5632 / 64) * 16, N2 = (1024 / 64) * (2816 / 64);
  for (int it = blockIdx.x; it < N1 + N2; it += gridDim.x) {
    if (it < N1) {
      cvt_tile<MapFfnIn, true>(p.w_ffn_in + (size_t)l * 1024 * 5632, 5632, W0, 1024, (it >> 4) * 64, (it & 15) * 64, nullptr, MapFfnIn(), tile);
    } else {
      const int j = it - N1;
      cvt_tile<MapIdent, true>(p.w_ffn_out + (size_t)l * 2816 * 1024, 1024, W1, 2816, (j / 44) * 64, (j % 44) * 64, nullptr, MapIdent{0}, tile);
    }
  }
}

DI void phase_prologue(const Params& p, float* smf) {
  const int tid = TIDX;
  float* sc = smf;
  float* red = smf + 5 * 1024;
  for (int i = tid; i < 5 * 1024; i += 256) {
    const int r = i >> 10, k = i & 1023;
    const float v = r < 4 ? p.c[r * 1024 + k] : p.c_ctx[k];
    sc[i] = siluf(v);
  }
  __syncthreads();
  float* modv = (float*)(p.ws + OFF_MODV);
  for (int it = blockIdx.x; it < 2 * 192; it += gridDim.x) {
    const int l = it / 192, n0 = (it % 192) * 32;
    const int col = tid & 31, kg = tid >> 5;
    float a[5] = {0.f, 0.f, 0.f, 0.f, 0.f};
    const float* w = p.w_mod + (size_t)l * 1024 * 6144 + n0 + col;
    for (int k = kg * 128; k < kg * 128 + 128; ++k) {
      const float wv = w[(size_t)k * 6144];
#pragma unroll
      for (int r = 0; r < 5; ++r) a[r] += sc[r * 1024 + k] * wv;
    }
#pragma unroll
    for (int r = 0; r < 5; ++r) red[(kg * 5 + r) * 32 + col] = a[r];
    __syncthreads();
    if (tid < 160) {
      const int r = tid >> 5, cl = tid & 31;
      float s = p.b_mod[l * 6144 + n0 + cl];
#pragma unroll
      for (int g = 0; g < 8; ++g) s += red[(g * 5 + r) * 32 + cl];
      modv[(l * 5 + r) * 6144 + n0 + cl] = s;
    }
    __syncthreads();
  }
  float* cosM = (float*)(p.ws + OFF_COSM);
  float* sinM = (float*)(p.ws + OFF_SINM);
  float* cosG = (float*)(p.ws + OFF_COSG);
  float* sinG = (float*)(p.ws + OFF_SING);
  const int gtid = blockIdx.x * 256 + tid, gn = gridDim.x * 256;
  for (int i = gtid; i < 4096 * 48; i += gn) {
    const int pos = i / 48, j = i % 48;
    const int prow = pos >> 6, pcol = pos & 63;
    float ang;
    if (j < 16) {
      const int f = j & 7;
      const float inv = exp2f(-(float)f * (13.287712379549449f / 8.f));
      ang = (float)(j < 8 ? prow : pcol) * inv;
    } else {
      const int jj = j - 16, f = jj & 15;
      const float inv = exp2f(-(float)f * (13.287712379549449f / 16.f));
      ang = (float)(jj < 16 ? prow : pcol) * inv;
    }
    float rev = ang * 0.15915494309189535f;
    rev -= floorf(rev);
    const float sn = __builtin_amdgcn_sinf(rev), cs = __builtin_amdgcn_cosf(rev);
    if (j < 16) { cosM[pos * 16 + j] = cs; sinM[pos * 16 + j] = sn; }
    else { cosG[pos * 32 + j - 16] = cs; sinG[pos * 32 + j - 16] = sn; }
  }
}

template <int MODE>
DI void ln_rows(const Params& p, int nrows, const float* srcL, const float* srcC, float* dstL, float* dstC,
                const float* lng, const float* lnb, const float* modl, int sh_off, int sc_off, u16* H, bool writeH, bool h16 = false) {
  const int lane = TIDX & 63;
  const int gw = (blockIdx.x * 256 + TIDX) >> 6, nw = (gridDim.x * 256) >> 6;
  for (int r = gw; r < nrows; r += nw) {
    const float* src = r < TL ? srcL + (size_t)r * D : srcC + (size_t)(r - TL) * D;
    f32x4 v[4];
#pragma unroll
    for (int i = 0; i < 4; ++i) v[i] = *(const f32x4*)(src + i * 256 + lane * 4);
    float s = 0.f;
#pragma unroll
    for (int i = 0; i < 4; ++i) s += v[i][0] + v[i][1] + v[i][2] + v[i][3];
    float mu = wave_sum(s) * (1.f / D);
    float q = 0.f;
#pragma unroll
    for (int i = 0; i < 4; ++i)
#pragma unroll
      for (int j = 0; j < 4; ++j) { const float d = v[i][j] - mu; q += d * d; }
    float rstd = rsqrtf(wave_sum(q) * (1.f / D) + EPS);
    if (MODE == 1) {
      float* dst = r < TL ? dstL + (size_t)r * D : dstC + (size_t)(r - TL) * D;
      s = 0.f;
#pragma unroll
      for (int i = 0; i < 4; ++i) {
        const f32x4 g = *(const f32x4*)(lng + i * 256 + lane * 4), b = *(const f32x4*)(lnb + i * 256 + lane * 4);
#pragma unroll
        for (int j = 0; j < 4; ++j) { v[i][j] = (v[i][j] - mu) * rstd * g[j] + b[j]; s += v[i][j]; }
        *(f32x4*)(dst + i * 256 + lane * 4) = v[i];
      }
      if (!writeH) continue;
      mu = wave_sum(s) * (1.f / D);
      q = 0.f;
#pragma unroll
      for (int i = 0; i < 4; ++i)
#pragma unroll
        for (int j = 0; j < 4; ++j) { const float d = v[i][j] - mu; q += d * d; }
      rstd = rsqrtf(wave_sum(q) * (1.f / D) + EPS);
    }
    const float* mrow = modl + row_mod(r) * 6144;
#pragma unroll
    for (int i = 0; i < 4; ++i) {
      const f32x4 sh = *(const f32x4*)(mrow + sh_off + i * 256 + lane * 4), sc = *(const f32x4*)(mrow + sc_off + i * 256 + lane * 4);
      f32x4 h;
#pragma unroll
      for (int j = 0; j < 4; ++j) h[j] = (v[i][j] - mu) * rstd * (1.f + sc[j]) + sh[j];
      if (h16) st_h4(H + (size_t)r * D + i * 256 + lane * 4, h); else st_bf4(H + (size_t)r * D + i * 256 + lane * 4, h);
    }
  }
}

DI void phase_inproj(const Params& p, int l, u16* smem) {
  const u16* H = (const u16*)(p.ws + OFF_H);
  const u16* W = (const u16*)(p.ws + OFF_W0);
  u16* Pmla = (u16*)(p.ws + OFF_PMLA);
  u16* Z = (u16*)(p.ws + OFF_Z);
  u16* XR = (u16*)(p.ws + OFF_XR);
  float* DT = (float*)(p.ws + OFF_DT);
  u16* Pgqa = (u16*)(p.ws + OFF_PGQA);
  u16* VtG = (u16*)(p.ws + OFF_VTG);
  const float* cosG = (const float*)(p.ws + OFF_COSG);
  const float* sinG = (const float*)(p.ws + OFF_SING);
  const int tid = TIDX, lane = tid & 63, wid = tid >> 6, wm = wid >> 1, wn = wid & 1, lr = lane & 15, lq = lane >> 4;
  constexpr int MT = T / 128, NT = WINP / 128;
  XCD_TILE_LOOP(MT, NT) {
    int mt, nt;
    tile_xcd(j_, blockIdx.x & 7, MT >> 3, NT, mt, nt);
    if (l == 1 && mt >= TL / 128 && ((nt >= 6 && nt < 14) || (nt >= 27 && nt < 31))) continue;
    f32x4 acc[4][4];
    zero_acc<4>(acc);
    gemm_core<4>(H + (size_t)mt * 128 * 1024, 1024, W + (size_t)nt * 128 * 1024, 1024, 1024, acc, smem);
    const int rbase = mt * 128 + wm * 64 + lr;
    const int cw = wn * 64 + lq * 4;
    if (nt < 6) {
#pragma unroll
      for (int mi = 0; mi < 4; ++mi)
#pragma unroll
        for (int ni = 0; ni < 4; ++ni) {
          const int col = nt * 128 + cw + ni * 16;
          if (col < 672) st_bf4(Pmla + (size_t)(rbase + mi * 16) * 672 + col, acc[mi][ni]);
        }
    } else if (nt < 14) {
#pragma unroll
      for (int mi = 0; mi < 4; ++mi)
#pragma unroll
        for (int ni = 0; ni < 4; ++ni) st_bf4(Z + (size_t)(rbase + mi * 16) * 1024 + (nt - 6) * 128 + cw + ni * 16, acc[mi][ni]);
    } else if (nt < 26) {
#pragma unroll
      for (int mi = 0; mi < 4; ++mi)
#pragma unroll
        for (int ni = 0; ni < 4; ++ni) st_bf4(XR + (size_t)(rbase + mi * 16) * 1536 + (nt - 14) * 128 + cw + ni * 16, acc[mi][ni]);
    } else if (nt == 26) {
      if (wn == 0) {
#pragma unroll
        for (int mi = 0; mi < 4; ++mi)
#pragma unroll
          for (int ni = 0; ni < 2; ++ni) *(f32x4*)(DT + (size_t)(rbase + mi * 16) * 32 + lq * 4 + ni * 16) = acc[mi][ni];
      }
    } else if (nt < 32) {
      const float* g = (nt < 31) ? p.g_q_gqa + l * 64 : p.g_k_gqa + l * 64;
      const int dcol = (nt < 31) ? (nt - 27) * 128 + wn * 64 : 512 + wn * 64;
      f32x4 gv[4];
#pragma unroll
      for (int ni = 0; ni < 4; ++ni) gv[ni] = *(const f32x4*)(g + ni * 16 + lq * 4);
#pragma unroll
      for (int mi = 0; mi < 4; ++mi) {
        const int row = rbase + mi * 16;
        float ss = 0.f;
#pragma unroll
        for (int ni = 0; ni < 4; ++ni)
#pragma unroll
          for (int j = 0; j < 4; ++j) ss += acc[mi][ni][j] * acc[mi][ni][j];
        ss = quad_sum(ss);
        const float rstd = rsqrtf(ss * (1.f / 64.f) + EPS);
        f32x4 y[4];
#pragma unroll
        for (int ni = 0; ni < 4; ++ni)
#pragma unroll
          for (int j = 0; j < 4; ++j) y[ni][j] = acc[mi][ni][j] * rstd * gv[ni][j];
        if (row < TL) {
          const int pos = row & 4095;
#pragma unroll
          for (int ni = 0; ni < 2; ++ni) {
            const f32x4 cs = *(const f32x4*)(cosG + pos * 32 + ni * 16 + lq * 4), sn = *(const f32x4*)(sinG + pos * 32 + ni * 16 + lq * 4);
#pragma unroll
            for (int j = 0; j < 4; ++j) {
              const float x1 = y[ni][j], x2 = y[ni + 2][j];
              y[ni][j] = x1 * cs[j] - x2 * sn[j];
              y[ni + 2][j] = x1 * sn[j] + x2 * cs[j];
            }
          }
        }
#pragma unroll
        for (int ni = 0; ni < 4; ++ni) st_bf4(Pgqa + (size_t)row * 640 + dcol + ni * 16 + lq * 4, y[ni]);
      }
    } else {
#pragma unroll
      for (int mi = 0; mi < 4; ++mi) {
        const int row = rbase + mi * 16;
        const int b = row_batch(row), key = row_key(row);
        u16* vt = VtG + ((size_t)(b * 2 + wn) * 64) * NKEY + key;
#pragma unroll
        for (int ni = 0; ni < 4; ++ni)
#pragma unroll
          for (int j = 0; j < 4; ++j) vt[(size_t)(ni * 16 + lq * 4 + j) * NKEY] = f2bf(acc[mi][ni][j]);
      }
    }
  }
}

DI unsigned conv_word(unsigned w0, unsigned w1, unsigned w2, const float* cw, const float* cb, int ch) {
  const float lo = cw[ch] * bflo(w0) + cw[1536 + ch] * bflo(w1) + cw[3072 + ch] * bflo(w2) + cb[ch];
  const float hi = cw[ch + 1] * bfhi(w0) + cw[1536 + ch + 1] * bfhi(w1) + cw[3072 + ch + 1] * bfhi(w2) + cb[ch + 1];
  return pk2(siluf(lo), siluf(hi));
}
DI float sq_word(unsigned w) { const float x = bflo(w), y = bfhi(w); return x * x + y * y; }
DI void phase_c1(const Params& p, int l) {
  const u16* XR = (const u16*)(p.ws + OFF_XR);
  u16* XBC = (u16*)(p.ws + OFF_XBC);
  float* DT = (float*)(p.ws + OFF_DT);
  const u16* Pmla = (const u16*)(p.ws + OFF_PMLA);
  float* stats = (float*)(p.ws + OFF_STATS);
  const float* cw = p.conv_w + (size_t)l * 3 * 1536;
  const float* cb = p.conv_b + (size_t)l * 1536;
  const int gtid = blockIdx.x * 256 + TIDX, gn = gridDim.x * 256;
  for (int i = gtid; i < (T / 32) * 192; i += gn) {
    const int seg = i / 192, ch0 = (i % 192) * 8;
    const int row0 = seg * 32;
    bool first, last;
    if (row0 < TL) { const int pl = row0 & 4095; first = pl == 0; last = pl == 4096 - 32; }
    else { const int pj = (row0 - TL) & 255; first = pj == 0; last = pj == 256 - 32; }
    float w0[8], w1[8], w2[8], bb[8];
#pragma unroll
    for (int k = 0; k < 8; ++k) { w0[k] = cw[ch0 + k]; w1[k] = cw[1536 + ch0 + k]; w2[k] = cw[3072 + ch0 + k]; bb[k] = cb[ch0 + k]; }
    const uint4 z4 = make_uint4(0u, 0u, 0u, 0u);
    uint4 up = z4;
    if (!first) up = *(const uint4*)(XR + (size_t)(row0 - 1) * 1536 + ch0);
    uint4 uc = *(const uint4*)(XR + (size_t)row0 * 1536 + ch0);
#pragma unroll 4
    for (int r = 0; r < 32; ++r) {
      const int row = row0 + r;
      uint4 un = z4;
      if (r < 31 || !last) un = *(const uint4*)(XR + (size_t)(row + 1) * 1536 + ch0);
      uint4 ov;
      {
        const float lo = w0[0] * bflo(up.x) + w1[0] * bflo(uc.x) + w2[0] * bflo(un.x) + bb[0];
        const float hi = w0[1] * bfhi(up.x) + w1[1] * bfhi(uc.x) + w2[1] * bfhi(un.x) + bb[1];
        ov.x = pk2(siluf(lo), siluf(hi));
      }
      {
        const float lo = w0[2] * bflo(up.y) + w1[2] * bflo(uc.y) + w2[2] * bflo(un.y) + bb[2];
        const float hi = w0[3] * bfhi(up.y) + w1[3] * bfhi(uc.y) + w2[3] * bfhi(un.y) + bb[3];
        ov.y = pk2(siluf(lo), siluf(hi));
      }
      {
        const float lo = w0[4] * bflo(up.z) + w1[4] * bflo(uc.z) + w2[4] * bflo(un.z) + bb[4];
        const float hi = w0[5] * bfhi(up.z) + w1[5] * bfhi(uc.z) + w2[5] * bfhi(un.z) + bb[5];
        ov.z = pk2(siluf(lo), siluf(hi));
      }
      {
        const float lo = w0[6] * bflo(up.w) + w1[6] * bflo(uc.w) + w2[6] * bflo(un.w) + bb[6];
        const float hi = w0[7] * bfhi(up.w) + w1[7] * bfhi(uc.w) + w2[7] * bfhi(un.w) + bb[7];
        ov.w = pk2(siluf(lo), siluf(hi));
      }
      *(uint4*)(XBC + (size_t)row * 1536 + ch0) = ov;
      up = uc;
      uc = un;
    }
  }
  for (int i = gtid; i < T * 32; i += gn) {
    const float v = DT[i] + p.dt_bias[l * 32 + (i & 31)];
    const float e = __expf(-fabsf(v));
    const float lp = e < 0.01f ? e * (1.f - e * (0.5f - e * (1.f / 3.f))) : __logf(1.f + e);
    DT[i] = fmaxf(v, 0.f) + lp;
  }
  const int lane = TIDX & 63;
  const int gw = gtid >> 6, nw = gn >> 6;
  for (int r = gw; r < T; r += nw) {
    float sq = 0.f, sk = 0.f;
    if (lane < 48) {
      const uint4 u = *(const uint4*)(Pmla + (size_t)r * 672 + lane * 8);
      sq = sq_word(u.x) + sq_word(u.y) + sq_word(u.z) + sq_word(u.w);
    }
    if (lane < 32) {
      const uint4 u = *(const uint4*)(Pmla + (size_t)r * 672 + 384 + lane * 8);
      sk = sq_word(u.x) + sq_word(u.y) + sq_word(u.z) + sq_word(u.w);
    }
    sq = wave_sum(sq);
    sk = wave_sum(sk);
    if (lane == 0) {
      stats[r * 2] = rsqrtf(sq * (1.f / 384.f) + EPS);
      stats[r * 2 + 1] = rsqrtf(sk * (1.f / 256.f) + EPS);
    }
  }
}

DI void phase_c2(const Params& p, int l, u16* smem) {
  const u16* Pmla = (const u16*)(p.ws + OFF_PMLA);
  const u16* W0 = (const u16*)(p.ws + OFF_W0);
  u16* Qm = (u16*)(p.ws + OFF_QM);
  u16* Km = (u16*)(p.ws + OFF_KM);
  u16* VtM = (u16*)(p.ws + OFF_VTM);
  const float* stats = (const float*)(p.ws + OFF_STATS);
  const float* cosM = (const float*)(p.ws + OFF_COSM);
  const float* sinM = (const float*)(p.ws + OFF_SINM);
  const int tid = TIDX, lane = tid & 63, wid = tid >> 6, wm = wid >> 1, wn = wid & 1, lr = lane & 15, lq = lane >> 4;
  constexpr int MT = T / 128;
  XCD_TILE_LOOP(MT, 14) {
    f32x4 acc[4][4];
    zero_acc<4>(acc);
    int mt, nt;
    tile_xcd(j_, blockIdx.x & 7, MT >> 3, 14, mt, nt);
    if (nt < 6) {
      gemm_core<4>(Pmla + (size_t)mt * 128 * 672, 672, W0 + W0_UQ + (size_t)nt * 128 * 384, 384, 384, acc, smem);
      const int rbase = mt * 128 + wm * 64 + lr;
      const int c0 = nt * 128 + wn * 64;
      const int g0 = c0 >> 4;
#pragma unroll
      for (int mi = 0; mi < 4; ++mi) {
        const int row = rbase + mi * 16;
        const float rs = stats[row * 2];
        f32x4 y[4];
#pragma unroll
        for (int ni = 0; ni < 4; ++ni) y[ni] = acc[mi][ni] * rs;
        if (row < TL) {
          const int pos = row & 4095;
          const f32x4 cs = *(const f32x4*)(cosM + pos * 16 + lq * 4), sn = *(const f32x4*)(sinM + pos * 16 + lq * 4);
#pragma unroll
          for (int ni = 0; ni < 3; ++ni) {
            if ((g0 + ni) % 6 == 4) {
#pragma unroll
              for (int j = 0; j < 4; ++j) {
                const float x1 = y[ni][j], x2 = y[ni + 1][j];
                y[ni][j] = x1 * cs[j] - x2 * sn[j];
                y[ni + 1][j] = x1 * sn[j] + x2 * cs[j];
              }
            }
          }
        }
#pragma unroll
        for (int ni = 0; ni < 4; ++ni) st_bf4(Qm + (size_t)row * 768 + c0 + ni * 16 + lq * 4, y[ni]);
      }
    } else {
      nt -= 6;
      gemm_core<4>(Pmla + (size_t)mt * 128 * 672 + 384, 672, W0 + W0_UKV + (size_t)nt * 128 * 256, 256, 256, acc, smem);
      const int rbase = mt * 128 + wm * 64 + lr;
#pragma unroll
      for (int mi = 0; mi < 4; ++mi) {
        const int row = rbase + mi * 16;
        const float rs = stats[row * 2 + 1];
        if (wn == 0) {
#pragma unroll
          for (int ni = 0; ni < 4; ++ni) st_bf4(Km + (size_t)row * 768 + nt * 96 + ni * 16 + lq * 4, acc[mi][ni] * rs);
        } else {
          const int b = row_batch(row), key = row_key(row);
          u16* vt = VtM + ((size_t)(b * 8 + nt) * 64) * NKEY + key;
#pragma unroll
          for (int ni = 0; ni < 4; ++ni)
#pragma unroll
            for (int j = 0; j < 4; ++j) vt[(size_t)(ni * 16 + lq * 4 + j) * NKEY] = f2bf(acc[mi][ni][j] * rs);
        }
      }
    }
  }
  const int gtid = blockIdx.x * 256 + tid, gn = gridDim.x * 256;
  for (int i = gtid; i < T * 16; i += gn) {
    const int row = i >> 4, j = i & 15;
    float x1 = bf2f(Pmla[(size_t)row * 672 + 640 + j]), x2 = bf2f(Pmla[(size_t)row * 672 + 656 + j]);
    if (row < TL) {
      const int pos = row & 4095;
      const float cs = cosM[pos * 16 + j], sn = sinM[pos * 16 + j];
      const float a = x1 * cs - x2 * sn, b = x1 * sn + x2 * cs;
      x1 = a; x2 = b;
    }
    const u16 h1 = f2bf(x1), h2 = f2bf(x2);
#pragma unroll
    for (int h = 0; h < 8; ++h) {
      Km[(size_t)row * 768 + h * 96 + 64 + j] = h1;
      Km[(size_t)row * 768 + h * 96 + 80 + j] = h2;
    }
  }
}

template <int DQK, bool NOMAX>
DI void attn_item(const u16* __restrict__ Q, int ldq, int qoff, const u16* __restrict__ Kp, int ldk, int koff,
                  const u16* __restrict__ Vt, u16* __restrict__ Y, int yoff, int b, int qrow0, int nkt, float sl2, float c0, u16* smem) {
  constexpr int KS = DQK / 32;
  constexpr int KB = KS * 4096, STG = KB + 8192;
  char* sbase = (char*)smem;
  const int tid = TIDX, lane = tid & 63, wid = tid >> 6, lr = lane & 15, lq = lane >> 4;
  bf16x8 qf[2][KS];
#pragma unroll
  for (int qi = 0; qi < 2; ++qi)
#pragma unroll
    for (int ks = 0; ks < KS; ++ks)
      qf[qi][ks] = *(const bf16x8*)(Q + (size_t)(qrow0 + wid * 32 + qi * 16 + lr) * ldq + qoff + ks * 32 + lq * 8);
  f32x4 o[4][2];
#pragma unroll
  for (int i = 0; i < 4; ++i)
#pragma unroll
    for (int j = 0; j < 2; ++j) o[i][j] = (f32x4){0.f, 0.f, 0.f, 0.f};
  float mrun[2] = {-1e30f, -1e30f}, lrun[2] = {0.f, 0.f};
  const int drow = tid >> 2, dch = (tid & 3) ^ ((drow >> 2) & 3);
  const u16* vsrc = Vt + (size_t)drow * NKEY + dch * 8;
#define ATT_ISSUE(KT, BUF)                                                                                           \
  {                                                                                                                  \
    const int kt_ = (KT) < nkt ? (KT) : nkt - 1;                                                                     \
    const int r0_ = kt_ < 4 ? TL + b * CTXL + kt_ * 64 : b * SEQ + (kt_ - 4) * 64;                                   \
    const u16* ksrc_ = Kp + (size_t)(r0_ + drow) * ldk + koff + dch * 8;                                             \
    _Pragma("unroll") for (int ks = 0; ks < KS; ++ks)                                                                \
        __builtin_amdgcn_global_load_lds((const GAS unsigned*)(ksrc_ + ks * 32),                                     \
                                         (LAS3 unsigned*)(sbase + (BUF) * STG + ks * 4096 + tid * 16), 16, 0, 0);    \
    _Pragma("unroll") for (int u = 0; u < 2; ++u)                                                                    \
        __builtin_amdgcn_global_load_lds((const GAS unsigned*)(vsrc + kt_ * 64 + u * 32),                            \
                                         (LAS3 unsigned*)(sbase + (BUF) * STG + KB + u * 4096 + tid * 16), 16, 0, 0); \
  }
  const unsigned lbase = (unsigned)(size_t)((LAS3 char*)sbase);
  const unsigned kaddr = lbase + lr * 64 + ((lq ^ ((lr >> 2) & 3)) << 4);
  const unsigned vaddr0 = lbase + KB + lr * 64 + ((((lq >> 1)) ^ ((lr >> 2) & 3)) << 4) + (lq & 1) * 8;
  const unsigned vaddr1 = lbase + KB + lr * 64 + ((((lq >> 1) + 2) ^ ((lr >> 2) & 3)) << 4) + (lq & 1) * 8;
#define LDSR128(dst, addr, off) asm volatile("ds_read_b128 %0, %1 offset:%2" : "=v"(dst) : "v"(addr), "n"(off))
#define LDSR64(dst, addr, off) asm volatile("ds_read_b64 %0, %1 offset:%2" : "=v"(dst) : "v"(addr), "n"(off))
#define ATT_COMPUTE(BUF)                                                                                             \
  {                                                                                                                  \
    f32x4 s[4][2];                                                                                                   \
    _Pragma("unroll") for (int kk = 0; kk < 4; ++kk) {                                                               \
      bf16x8 kf[KS];                                                                                                 \
      LDSR128(kf[0], kaddr, (BUF) * STG + 0 * 4096 + kk * 1024);                                                     \
      LDSR128(kf[1], kaddr, (BUF) * STG + 1 * 4096 + kk * 1024);                                                     \
      if (KS == 3) LDSR128(kf[KS - 1], kaddr, (BUF) * STG + 2 * 4096 + kk * 1024);                                   \
      if (KS == 3) asm volatile("s_waitcnt lgkmcnt(0)" : "+v"(kf[0]), "+v"(kf[1]), "+v"(kf[KS - 1]));                \
      else asm volatile("s_waitcnt lgkmcnt(0)" : "+v"(kf[0]), "+v"(kf[1]));                                          \
      s[kk][0] = (f32x4){0.f, 0.f, 0.f, 0.f};                                                                        \
      s[kk][1] = (f32x4){0.f, 0.f, 0.f, 0.f};                                                                        \
      _Pragma("unroll") for (int ks = 0; ks < KS; ++ks) {                                                            \
        s[kk][0] = mma16<true>(kf[ks], qf[0][ks], s[kk][0]);                    \
        s[kk][1] = mma16<true>(kf[ks], qf[1][ks], s[kk][1]);                    \
      }                                                                                                              \
    }                                                                                                                \
    uint2 vlo[2][4], vhi[2][4];                                                                                      \
    _Pragma("unroll") for (int u = 0; u < 2; ++u) {                                                                  \
      LDSR64(vlo[u][0], vaddr0, (BUF) * STG + u * 4096 + 0 * 1024); LDSR64(vhi[u][0], vaddr1, (BUF) * STG + u * 4096 + 0 * 1024); \
      LDSR64(vlo[u][1], vaddr0, (BUF) * STG + u * 4096 + 1 * 1024); LDSR64(vhi[u][1], vaddr1, (BUF) * STG + u * 4096 + 1 * 1024); \
      LDSR64(vlo[u][2], vaddr0, (BUF) * STG + u * 4096 + 2 * 1024); LDSR64(vhi[u][2], vaddr1, (BUF) * STG + u * 4096 + 2 * 1024); \
      LDSR64(vlo[u][3], vaddr0, (BUF) * STG + u * 4096 + 3 * 1024); LDSR64(vhi[u][3], vaddr1, (BUF) * STG + u * 4096 + 3 * 1024); \
    }                                                                                                                \
    bf16x8 pf[2][2];                                                                                                 \
    _Pragma("unroll") for (int qi = 0; qi < 2; ++qi) {                                                               \
      float ps = 0.f;                                                                                                \
      float pv[4][4];                                                                                                \
      if (NOMAX) {                                                                                                   \
        _Pragma("unroll") for (int kk = 0; kk < 4; ++kk)                                                             \
            _Pragma("unroll") for (int j = 0; j < 4; ++j) {                                                          \
          const float e = __builtin_amdgcn_exp2f(s[kk][qi][j] * sl2 - c0);                                           \
          pv[kk][j] = e;                                                                                             \
          ps += e;                                                                                                   \
        }                                                                                                            \
      } else {                                                                                                       \
        float mx = -1e30f;                                                                                           \
        _Pragma("unroll") for (int kk = 0; kk < 4; ++kk)                                                             \
            _Pragma("unroll") for (int j = 0; j < 4; ++j) mx = fmaxf(mx, s[kk][qi][j]);                              \
        mx = quad_max(mx);                                                                                           \
        const float mnew = fmaxf(mrun[qi], mx * sl2);                                                                \
        const float alpha = __builtin_amdgcn_exp2f(mrun[qi] - mnew);                                                 \
        mrun[qi] = mnew;                                                                                             \
        _Pragma("unroll") for (int kk = 0; kk < 4; ++kk)                                                             \
            _Pragma("unroll") for (int j = 0; j < 4; ++j) {                                                          \
          const float e = __builtin_amdgcn_exp2f(s[kk][qi][j] * sl2 - mnew);                                         \
          pv[kk][j] = e;                                                                                             \
          ps += e;                                                                                                   \
        }                                                                                                            \
        if (__builtin_amdgcn_ballot_w64(alpha != 1.0f)) {                                                            \
          lrun[qi] *= alpha;                                                                                         \
          _Pragma("unroll") for (int dt = 0; dt < 4; ++dt) o[dt][qi] *= alpha;                                       \
        }                                                                                                            \
      }                                                                                                              \
      lrun[qi] += ps;                                                                                                \
      _Pragma("unroll") for (int u = 0; u < 2; ++u) {                                                                \
        union { bf16x8 v; unsigned w[4]; } pk;                                                                       \
        pk.w[0] = pk2(pv[2 * u][0], pv[2 * u][1]);                                                                   \
        pk.w[1] = pk2(pv[2 * u][2], pv[2 * u][3]);                                                                   \
        pk.w[2] = pk2(pv[2 * u + 1][0], pv[2 * u + 1][1]);                                                           \
        pk.w[3] = pk2(pv[2 * u + 1][2], pv[2 * u + 1][3]);                                                           \
        pf[qi][u] = pk.v;                                                                                            \
      }                                                                                                              \
    }                                                                                                                \
    asm volatile("s_waitcnt lgkmcnt(0)"                                                                              \
                 : "+v"(vlo[0][0]), "+v"(vlo[0][1]), "+v"(vlo[0][2]), "+v"(vlo[0][3]), "+v"(vhi[0][0]), "+v"(vhi[0][1]), \
                   "+v"(vhi[0][2]), "+v"(vhi[0][3]), "+v"(vlo[1][0]), "+v"(vlo[1][1]), "+v"(vlo[1][2]), "+v"(vlo[1][3]), \
                   "+v"(vhi[1][0]), "+v"(vhi[1][1]), "+v"(vhi[1][2]), "+v"(vhi[1][3]));                              \
    _Pragma("unroll") for (int u = 0; u < 2; ++u)                                                                    \
        _Pragma("unroll") for (int dt = 0; dt < 4; ++dt) {                                                           \
      union { bf16x8 v; uint2 h[2]; } vf;                                                                            \
      vf.h[0] = vlo[u][dt];                                                                                          \
      vf.h[1] = vhi[u][dt];                                                                                          \
      o[dt][0] = mma16<true>(vf.v, pf[0][u], o[dt][0]);                         \
      o[dt][1] = mma16<true>(vf.v, pf[1][u], o[dt][1]);                         \
    }                                                                                                                \
  }
  if (DQK == 64 && NOMAX) {
    f32x4 sc[4][2], sn[4][2];
#define ATT_KREAD(BUF)                                                                                               \
    _Pragma("unroll") for (int kk = 0; kk < 4; ++kk) {                                                               \
      LDSR128(kf[kk][0], kaddr, (BUF) * STG + 0 * 4096 + kk * 1024);                                                 \
      LDSR128(kf[kk][1], kaddr, (BUF) * STG + 1 * 4096 + kk * 1024);                                                 \
    }
#define ATT_VREAD(BUF)                                                                                               \
    _Pragma("unroll") for (int u = 0; u < 2; ++u) {                                                                  \
      LDSR64(vlo[u][0], vaddr0, (BUF) * STG + u * 4096 + 0 * 1024); LDSR64(vhi[u][0], vaddr1, (BUF) * STG + u * 4096 + 0 * 1024); \
      LDSR64(vlo[u][1], vaddr0, (BUF) * STG + u * 4096 + 1 * 1024); LDSR64(vhi[u][1], vaddr1, (BUF) * STG + u * 4096 + 1 * 1024); \
      LDSR64(vlo[u][2], vaddr0, (BUF) * STG + u * 4096 + 2 * 1024); LDSR64(vhi[u][2], vaddr1, (BUF) * STG + u * 4096 + 2 * 1024); \
      LDSR64(vlo[u][3], vaddr0, (BUF) * STG + u * 4096 + 3 * 1024); LDSR64(vhi[u][3], vaddr1, (BUF) * STG + u * 4096 + 3 * 1024); \
    }
#define ATT_KWAIT()                                                                                                  \
    asm volatile("s_waitcnt lgkmcnt(0)" : "+v"(kf[0][0]), "+v"(kf[0][1]), "+v"(kf[1][0]), "+v"(kf[1][1]), "+v"(kf[2][0]), "+v"(kf[2][1]), "+v"(kf[3][0]), "+v"(kf[3][1]));
#define ATT_VWAIT()                                                                                                  \
    asm volatile("s_waitcnt lgkmcnt(0)"                                                                              \
                 : "+v"(vlo[0][0]), "+v"(vlo[0][1]), "+v"(vlo[0][2]), "+v"(vlo[0][3]), "+v"(vhi[0][0]), "+v"(vhi[0][1]), \
                   "+v"(vhi[0][2]), "+v"(vhi[0][3]), "+v"(vlo[1][0]), "+v"(vlo[1][1]), "+v"(vlo[1][2]), "+v"(vlo[1][3]), \
                   "+v"(vhi[1][0]), "+v"(vhi[1][1]), "+v"(vhi[1][2]), "+v"(vhi[1][3]));
#define ATT_SMMA(s)                                                                                                  \
    _Pragma("unroll") for (int kk = 0; kk < 4; ++kk) {                                                               \
      s[kk][0] = (f32x4){0.f, 0.f, 0.f, 0.f};                                                                        \
      s[kk][1] = (f32x4){0.f, 0.f, 0.f, 0.f};                                                                        \
      _Pragma("unroll") for (int ks = 0; ks < 2; ++ks) {                                                             \
        s[kk][0] = mma16<true>(kf[kk][ks], qf[0][ks], s[kk][0]);                                                     \
        s[kk][1] = mma16<true>(kf[kk][ks], qf[1][ks], s[kk][1]);                                                     \
      }                                                                                                              \
    }
#define ATT_STEP2(KT, ST, SN)                                                                                        \
    if ((KT) < nkt) {                                                                                                \
      asm volatile("s_waitcnt vmcnt(0)" ::: "memory");                                                               \
      __builtin_amdgcn_s_barrier();                                                                                  \
      ATT_ISSUE((KT) + 2, ((ST) + 2) % 3)                                                                            \
      bf16x8 kf[4][2];                                                                                               \
      uint2 vlo[2][4], vhi[2][4];                                                                                    \
      if ((KT) + 1 < nkt) { ATT_KREAD(SN) } else { ATT_KREAD(ST) }                                                   \
      ATT_KWAIT()                                                                                                    \
      ATT_VREAD(ST)                                                                                                  \
      ATT_SMMA(sn)                                                                                                   \
      bf16x8 pf[2][2];                                                                                               \
      _Pragma("unroll") for (int qi = 0; qi < 2; ++qi) {                                                             \
        float ps = 0.f;                                                                                              \
        float pv[4][4];                                                                                              \
        _Pragma("unroll") for (int kk = 0; kk < 4; ++kk)                                                             \
            _Pragma("unroll") for (int j = 0; j < 4; ++j) {                                                          \
          const float e = __builtin_amdgcn_exp2f(sc[kk][qi][j] * sl2 - c0);                                          \
          pv[kk][j] = e;                                                                                             \
          ps += e;                                                                                                   \
        }                                                                                                            \
        lrun[qi] += ps;                                                                                              \
        _Pragma("unroll") for (int u = 0; u < 2; ++u) {                                                              \
          union { bf16x8 v; unsigned w[4]; } pk;                                                                     \
          pk.w[0] = pk2(pv[2 * u][0], pv[2 * u][1]);                                                                 \
          pk.w[1] = pk2(pv[2 * u][2], pv[2 * u][3]);                                                                 \
          pk.w[2] = pk2(pv[2 * u + 1][0], pv[2 * u + 1][1]);                                                         \
          pk.w[3] = pk2(pv[2 * u + 1][2], pv[2 * u + 1][3]);                                                         \
          pf[qi][u] = pk.v;                                                                                          \
        }                                                                                                            \
      }                                                                                                              \
      ATT_VWAIT()                                                                                                    \
      _Pragma("unroll") for (int u = 0; u < 2; ++u)                                                                  \
          _Pragma("unroll") for (int dt = 0; dt < 4; ++dt) {                                                         \
        union { bf16x8 v; uint2 h[2]; } vf;                                                                          \
        vf.h[0] = vlo[u][dt];                                                                                        \
        vf.h[1] = vhi[u][dt];                                                                                        \
        o[dt][0] = mma16<true>(vf.v, pf[0][u], o[dt][0]);                                                            \
        o[dt][1] = mma16<true>(vf.v, pf[1][u], o[dt][1]);                                                            \
      }                                                                                                              \
      _Pragma("unroll") for (int kk = 0; kk < 4; ++kk) { sc[kk][0] = sn[kk][0]; sc[kk][1] = sn[kk][1]; }             \
    }
    ATT_ISSUE(0, 0)
    ATT_ISSUE(1, 1)
    asm volatile("s_waitcnt vmcnt(%0)" ::"n"(KS + 2) : "memory");
    __builtin_amdgcn_s_barrier();
    {
      bf16x8 kf[4][2];
      ATT_KREAD(0)
      asm volatile("s_waitcnt lgkmcnt(0)" : "+v"(kf[0][0]), "+v"(kf[0][1]), "+v"(kf[1][0]), "+v"(kf[1][1]), "+v"(kf[2][0]), "+v"(kf[2][1]), "+v"(kf[3][0]), "+v"(kf[3][1]));
      ATT_SMMA(sc)
    }
    for (int kt = 0; kt < nkt; kt += 3) {
      ATT_STEP2(kt, 0, 1)
      ATT_STEP2(kt + 1, 1, 2)
      ATT_STEP2(kt + 2, 2, 0)
    }
    asm volatile("s_waitcnt vmcnt(0)" ::: "memory");
    __builtin_amdgcn_s_barrier();
#undef ATT_STEP2
#undef ATT_SMMA
#undef ATT_VWAIT
#undef ATT_KWAIT
#undef ATT_VREAD
#undef ATT_KREAD
  } else {
#define ATT_STEP(KT, ST)                                                                                             \
  if ((KT) < nkt) {                                                                                                  \
    asm volatile("s_waitcnt vmcnt(%0)" ::"n"(KS + 2) : "memory");                                                    \
    __builtin_amdgcn_s_barrier();                                                                                    \
    ATT_ISSUE((KT) + 2, ((ST) + 2) % 3)                                                                              \
    ATT_COMPUTE(ST)                                                                                                  \
  }
  ATT_ISSUE(0, 0)
  ATT_ISSUE(1, 1)
  for (int kt = 0; kt < nkt; kt += 3) {
    ATT_STEP(kt, 0)
    ATT_STEP(kt + 1, 1)
    ATT_STEP(kt + 2, 2)
  }
  asm volatile("s_waitcnt vmcnt(0)" ::: "memory");
  __builtin_amdgcn_s_barrier();
  }
#undef ATT_STEP
#undef ATT_COMPUTE
#undef ATT_ISSUE
#undef LDSR128
#undef LDSR64
#pragma unroll
  for (int qi = 0; qi < 2; ++qi) {
    const float lt = quad_sum(lrun[qi]);
    const float inv = 1.f / lt;
    const int row = qrow0 + wid * 32 + qi * 16 + lr;
#pragma unroll
    for (int dt = 0; dt < 4; ++dt) st_bf4(Y + (size_t)row * 512 + yoff + dt * 16 + lq * 4, o[dt][qi] * inv);
  }
}

DI void phase_attn(const Params& p, int l, bool with_ctx, u16* smem) {
  const u16* Qm = (const u16*)(p.ws + OFF_QM);
  const u16* Km = (const u16*)(p.ws + OFF_KM);
  const u16* VtM = (const u16*)(p.ws + OFF_VTM);
  u16* Ymla = (u16*)(p.ws + OFF_YMLA);
  const u16* Pgqa = (const u16*)(p.ws + OFF_PGQA);
  const u16* VtG = (const u16*)(p.ws + OFF_VTG);
  u16* Ygqa = (u16*)(p.ws + OFF_YGQA);
  const float sl2_mla = 0.10206207261596575f * 1.4426950408889634f;
  const float sl2_gqa = 0.125f * 1.4426950408889634f;
  float c0_gqa;
  {
    const int ln = TIDX & 63;
    float gq = fabsf(p.g_q_gqa[l * 64 + ln]), gk = fabsf(p.g_k_gqa[l * 64 + ln]);
#pragma unroll
    for (int o = 32; o > 0; o >>= 1) { gq = fmaxf(gq, __shfl_xor(gq, o)); gk = fmaxf(gk, __shfl_xor(gk, o)); }
    const float bound = 8.f * gq * gk * 1.01f;
    c0_gqa = fmaxf(0.f, bound - 10.f) * 1.4426950408889634f;
  }
  const int xcd = blockIdx.x & 7, slots = gridDim.x >> 3;
  const int per_xcd = 256 + (with_ctx ? 16 : 0);
  for (int q = blockIdx.x >> 3; q < per_xcd; q += slots) {
    int kind, b, h, qrow0, nkt;
    if (q < 128) {
      const int P = xcd * 4 + (q >> 5);
      kind = 0; b = P >> 3; h = P & 7;
      qrow0 = b * SEQ + (q & 31) * 128;
      nkt = NKEY / 64;
    } else if (q < 256) {
      const int q2 = q - 128;
      kind = 1; b = xcd >> 1; h = (xcd & 1) * 4 + (q2 >> 5);
      qrow0 = b * SEQ + (q2 & 31) * 128;
      nkt = NKEY / 64;
    } else {
      const int q3 = q - 256;
      kind = q3 & 1;
      const int j = xcd * 8 + (q3 >> 1);
      const int qt = j & 1; h = (j >> 1) & 7; b = j >> 4;
      qrow0 = TL + b * CTXL + qt * 128;
      nkt = CTXL / 64;
    }
    if (kind == 0)
      attn_item<96, false>(Qm, 768, h * 96, Km, 768, h * 96, VtM + (size_t)(b * 8 + h) * 64 * NKEY, Ymla, h * 64, b, qrow0, nkt, sl2_mla, 0.f, smem);
    else
      attn_item<64, true>(Pgqa, 640, h * 64, Pgqa, 640, 512 + (h >> 2) * 64, VtG + (size_t)(b * 2 + (h >> 2)) * 64 * NKEY, Ygqa, h * 64, b, qrow0, nkt, sl2_gqa, c0_gqa, smem);
  }
}

DI int chunk_row0(int b, int m) { return m < 2 ? TL + b * CTXL + m * 128 : b * SEQ + (m - 2) * 128; }
DI int chunk_scan_idx(int dir, int m) { return dir == 0 ? m : (m < 2 ? 1 - m : 35 - m); }
constexpr int LDX = 136;

DI void ssd_cums(const Params& p, int l, int h, int r0, float* sw, float* scum, float* sdt, float& tot_out) {
  const int lane = TIDX & 63, dir = TIDX >> 6;
  const float* DT = (const float*)(p.ws + OFF_DT);
  const float a = -__expf(p.a_log[l * 32 + dir * 16 + h]);
  const int k0 = lane * 2;
  const float d0 = DT[(size_t)(r0 + k0) * 32 + dir * 16 + h], d1 = DT[(size_t)(r0 + k0 + 1) * 32 + dir * 16 + h];
  const float v0 = a * d0, v1 = a * d1;
  float inc = v0 + v1;
#pragma unroll
  for (int off = 1; off < 64; off <<= 1) {
    const float t = __shfl_up(inc, off);
    if (lane >= off) inc += t;
  }
  const float c1 = inc, c0 = inc - v1;
  const float tot = __shfl(inc, 63);
  tot_out = tot;
  if (dir == 0) {
    sw[k0] = __expf(tot - c0) * d0;
    sw[k0 + 1] = __expf(tot - c1) * d1;
    scum[k0] = c0;
    scum[k0 + 1] = c1;
  } else {
    sw[128 + k0] = __expf(c0 - v0) * d0;
    sw[128 + k0 + 1] = __expf(c1 - v1) * d1;
    scum[128 + k0] = tot - c0 + v0;
    scum[128 + k0 + 1] = tot - c1 + v1;
  }
  sdt[dir * 128 + k0] = d0;
  sdt[dir * 128 + k0 + 1] = d1;
}

struct XRegs { uint4 u[4]; };
DI XRegs ssd_load_x(const u16* XBC, int r0, int h) {
  const int lane = TIDX & 63, wid = TIDX >> 6;
  const int k0 = lane * 2;
  XRegs x;
#pragma unroll
  for (int it = 0; it < 2; ++it) {
    const int cn = wid + 4 * it;
    x.u[2 * it] = *(const uint4*)(XBC + (size_t)(r0 + k0) * 1536 + h * 64 + cn * 8);
    x.u[2 * it + 1] = *(const uint4*)(XBC + (size_t)(r0 + k0 + 1) * 1536 + h * 64 + cn * 8);
  }
  return x;
}
DI void ssd_write_xt(const XRegs& x, const float* scale, u16* sXt) {
  const int lane = TIDX & 63, wid = TIDX >> 6;
  const int k0 = lane * 2;
#pragma unroll
  for (int it = 0; it < 2; ++it) {
    const int cn = wid + 4 * it;
    const uint4 u0 = x.u[2 * it], u1 = x.u[2 * it + 1];
#pragma unroll
    for (int dir = 0; dir < 2; ++dir) {
      const float s0 = scale[dir * 128 + k0], s1 = scale[dir * 128 + k0 + 1];
      u16* dst = sXt + dir * 64 * LDX + (cn * 8) * LDX + k0;
      *(unsigned*)(dst + 0 * LDX) = pk2(bflo(u0.x) * s0, bflo(u1.x) * s1);
      *(unsigned*)(dst + 1 * LDX) = pk2(bfhi(u0.x) * s0, bfhi(u1.x) * s1);
      *(unsigned*)(dst + 2 * LDX) = pk2(bflo(u0.y) * s0, bflo(u1.y) * s1);
      *(unsigned*)(dst + 3 * LDX) = pk2(bfhi(u0.y) * s0, bfhi(u1.y) * s1);
      *(unsigned*)(dst + 4 * LDX) = pk2(bflo(u0.z) * s0, bflo(u1.z) * s1);
      *(unsigned*)(dst + 5 * LDX) = pk2(bfhi(u0.z) * s0, bfhi(u1.z) * s1);
      *(unsigned*)(dst + 6 * LDX) = pk2(bflo(u0.w) * s0, bflo(u1.w) * s1);
      *(unsigned*)(dst + 7 * LDX) = pk2(bfhi(u0.w) * s0, bfhi(u1.w) * s1);
    }
  }
}

DI void phase_ssd_states(const Params& p, int l, u16* smem) {
  const u16* XBC = (const u16*)(p.ws + OFF_XBC);
  u16* S = (u16*)(p.ws + OFF_S);
  float* chdec = (float*)(p.ws + OFF_CHDEC);
  u16* sBt = smem;
  u16* sXt = smem + 128 * LDX;
  float* sw = (float*)(smem + 256 * LDX);
  float* scum = sw + 256;
  float* sdt = scum + 256;
  const int tid = TIDX, lane = tid & 63, wid = tid >> 6, lr = lane & 15, lq = lane >> 4;
  for (int it = blockIdx.x; it < NBATCH * NCH * 16; it += gridDim.x) {
    const int h = it & 15, m = (it >> 4) % NCH, b = it / (16 * NCH);
    const int r0 = chunk_row0(b, m), g = h >> 3;
    if (wid < 2) {
      float tot;
      ssd_cums(p, l, h, r0, sw, scum, sdt, tot);
      if (lane == 0) chdec[((wid * 4 + b) * NCH + chunk_scan_idx(wid, m)) * 16 + h] = __expf(tot);
    }
    {
      const int k0 = lane * 2;
#pragma unroll
      for (int i4 = 0; i4 < 4; ++i4) {
        const int cn = wid + 4 * i4;
        const uint4 u0 = *(const uint4*)(XBC + (size_t)(r0 + k0) * 1536 + 1024 + g * 128 + cn * 8);
        const uint4 u1 = *(const uint4*)(XBC + (size_t)(r0 + k0 + 1) * 1536 + 1024 + g * 128 + cn * 8);
        const unsigned a0[4] = {u0.x, u0.y, u0.z, u0.w}, a1[4] = {u1.x, u1.y, u1.z, u1.w};
        u16* dst = sBt + (cn * 8) * LDX + k0;
#pragma unroll
        for (int e = 0; e < 4; ++e) {
          *(unsigned*)(dst + (2 * e) * LDX) = (a0[e] & 0xffffu) | (a1[e] << 16);
          *(unsigned*)(dst + (2 * e + 1) * LDX) = (a0[e] >> 16) | (a1[e] & 0xffff0000u);
        }
      }
    }
    const XRegs xr = ssd_load_x(XBC, r0, h);
    __syncthreads();
    ssd_write_xt(xr, sw, sXt);
    __syncthreads();
    {
      const int dir = wid >> 1, nh = wid & 1;
      f32x4 acc[4][4];
      zero_acc<4>(acc);
      const u16* b_s = sBt + (nh * 64 + lr) * LDX + lq * 8;
      const u16* x_s = sXt + dir * 64 * LDX + lr * LDX + lq * 8;
#pragma unroll
      for (int ks = 0; ks < 4; ++ks) {
        bf16x8 bfv[4], xf[4];
#pragma unroll
        for (int i = 0; i < 4; ++i) {
          bfv[i] = *(const bf16x8*)(b_s + i * 16 * LDX + ks * 32);
          xf[i] = *(const bf16x8*)(x_s + i * 16 * LDX + ks * 32);
        }
#pragma unroll
        for (int pt = 0; pt < 4; ++pt)
#pragma unroll
          for (int nt = 0; nt < 4; ++nt)
            acc[pt][nt] = mma16<true>(bfv[nt], xf[pt], acc[pt][nt]);
      }
      u16* dst = S + ((((size_t)(dir * 4 + b) * NCH + chunk_scan_idx(dir, m)) * 16 + h) * 64) * 128;
#pragma unroll
      for (int pt = 0; pt < 4; ++pt)
#pragma unroll
        for (int nt = 0; nt < 4; ++nt) st_bf4(dst + (size_t)(pt * 16 + lr) * 128 + nh * 64 + nt * 16 + lq * 4, acc[pt][nt]);
    }
    __syncthreads();
  }
}

DI void phase_ssd_scan(const Params& p) {
  u16* S = (u16*)(p.ws + OFF_S);
  const float* chdec = (const float*)(p.ws + OFF_CHDEC);
  const int gtid = blockIdx.x * 256 + TIDX, gn = gridDim.x * 256;
  for (int i = gtid; i < 2 * 4 * 16 * 2048; i += gn) {
    const int e4 = i & 2047, h = (i >> 11) & 15, db = i >> 15;
    float hp[4] = {0.f, 0.f, 0.f, 0.f};
    u16* ptr = S + (((size_t)db * NCH) * 16 + h) * 8192 + e4 * 4;
    const float* dc = chdec + (db * NCH) * 16 + h;
    uint2 u[NCH];
#pragma unroll
    for (int c = 0; c < NCH; ++c) u[c] = *(const uint2*)(ptr + (size_t)c * 16 * 8192);
#pragma unroll
    for (int c = 0; c < NCH; ++c) {
      const float d = dc[c * 16];
      uint2 w;
      w.x = pk2(hp[0], hp[1]);
      w.y = pk2(hp[2], hp[3]);
      *(uint2*)(ptr + (size_t)c * 16 * 8192) = w;
      hp[0] = d * hp[0] + bflo(u[c].x);
      hp[1] = d * hp[1] + bfhi(u[c].x);
      hp[2] = d * hp[2] + bflo(u[c].y);
      hp[3] = d * hp[3] + bfhi(u[c].y);
    }
  }
}

DI void phase_ssd_y(const Params& p, int l, bool with_ctx, u16* smem) {
  const u16* XBC = (const u16*)(p.ws + OFF_XBC);
  const u16* S = (const u16*)(p.ws + OFF_S);
  u16* Yssd = (u16*)(p.ws + OFF_YSSD);
  u16* sB = smem;
  u16* sXt = smem + 128 * LDX;
  float* sw = (float*)(smem + 256 * LDX);
  float* scum = sw + 256;
  float* sdt = scum + 256;
  const int tid = TIDX, lane = tid & 63, wid = tid >> 6, lr = lane & 15, lq = lane >> 4;
  const int m_lo = with_ctx ? 0 : 2;
  const int nm = NCH - m_lo;
  for (int it = blockIdx.x; it < NBATCH * nm * 16; it += gridDim.x) {
    const int h = it & 15, m = m_lo + (it >> 4) % nm, b = it / (16 * nm);
    const int r0 = chunk_row0(b, m), g = h >> 3;
    if (wid < 2) {
      float tot;
      ssd_cums(p, l, h, r0, sw, scum, sdt, tot);
    }
    {
      const u16* hin0 = S + ((((size_t)(0 * 4 + b) * NCH + chunk_scan_idx(0, m)) * 16 + h) * 64) * 128;
      const u16* hin1 = S + ((((size_t)(1 * 4 + b) * NCH + chunk_scan_idx(1, m)) * 16 + h) * 64) * 128;
#pragma unroll
      for (int i = 0; i < 8; ++i) {
        const int id = tid + 256 * i, dir = id >> 10, rem = id & 1023, rr = rem >> 4, cc = rem & 15;
        *(uint4*)(sB + dir * 64 * LDX + rr * LDX + cc * 8) = *(const uint4*)((dir ? hin1 : hin0) + rr * 128 + cc * 8);
      }
    }
    const XRegs xr = ssd_load_x(XBC, r0, h);
    __syncthreads();
    ssd_write_xt(xr, sdt, sXt);
    f32x4 acc0[2][4], acc1[2][4];
#pragma unroll
    for (int qi = 0; qi < 2; ++qi) {
      const int q = wid * 32 + qi * 16 + lr;
      bf16x8 cf[4];
#pragma unroll
      for (int ks = 0; ks < 4; ++ks) cf[ks] = *(const bf16x8*)(XBC + (size_t)(r0 + q) * 1536 + 1280 + g * 128 + ks * 32 + lq * 8);
#pragma unroll
      for (int dir = 0; dir < 2; ++dir) {
        f32x4 t[4];
#pragma unroll
        for (int pt = 0; pt < 4; ++pt) t[pt] = (f32x4){0.f, 0.f, 0.f, 0.f};
#pragma unroll
        for (int ks = 0; ks < 4; ++ks)
#pragma unroll
          for (int pt = 0; pt < 4; ++pt) {
            const bf16x8 hf = *(const bf16x8*)(sB + dir * 64 * LDX + (pt * 16 + lr) * LDX + ks * 32 + lq * 8);
            t[pt] = mma16<true>(hf, cf[ks], t[pt]);
          }
        const float e = __expf(scum[dir * 128 + q]);
#pragma unroll
        for (int pt = 0; pt < 4; ++pt) { if (qi == 0) acc0[dir][pt] = t[pt] * e; else acc1[dir][pt] = t[pt] * e; }
      }
      __builtin_amdgcn_sched_barrier(0);
    }
    __syncthreads();
#pragma unroll
    for (int i = 0; i < 8; ++i) {
      const int id = tid + 256 * i, rr = id >> 4, cc = id & 15;
      *(uint4*)(sB + rr * LDX + cc * 8) = *(const uint4*)(XBC + (size_t)(r0 + rr) * 1536 + 1024 + g * 128 + cc * 8);
    }
    __syncthreads();
    const float dsk = p.d_skip[l * 16 + h];
#pragma unroll 1
    for (int qi = 0; qi < 2; ++qi) {
      const int q = wid * 32 + qi * 16 + lr;
      f32x4 acc[2][4];
#pragma unroll
      for (int dir = 0; dir < 2; ++dir)
#pragma unroll
        for (int pt = 0; pt < 4; ++pt)
#pragma unroll
          for (int j = 0; j < 4; ++j) acc[dir][pt][j] = qi == 0 ? acc0[dir][pt][j] : acc1[dir][pt][j];
      const float cq0 = scum[q], cq1 = scum[128 + q];
      bf16x8 cf[4];
#pragma unroll
      for (int ks = 0; ks < 4; ++ks) cf[ks] = *(const bf16x8*)(XBC + (size_t)(r0 + q) * 1536 + 1280 + g * 128 + ks * 32 + lq * 8);
#pragma unroll 1
      for (int u = 0; u < 4; ++u) {
        f32x4 sc[2];
#pragma unroll
        for (int half = 0; half < 2; ++half) {
          sc[half] = (f32x4){0.f, 0.f, 0.f, 0.f};
#pragma unroll
          for (int ks = 0; ks < 4; ++ks) {
            const bf16x8 bfv = *(const bf16x8*)(sB + ((2 * u + half) * 16 + lr) * LDX + ks * 32 + lq * 8);
            sc[half] = mma16<true>(bfv, cf[ks], sc[half]);
          }
        }
#pragma unroll
        for (int dir = 0; dir < 2; ++dir) {
          const float cq = dir == 0 ? cq0 : cq1;
          union { bf16x8 v; unsigned w[4]; } gp;
#pragma unroll
          for (int half = 0; half < 2; ++half) {
            const int k0 = (2 * u + half) * 16 + lq * 4;
            const f32x4 ck4 = *(const f32x4*)(scum + dir * 128 + k0);
            float gv[4];
#pragma unroll
            for (int j = 0; j < 4; ++j) {
              const int k = k0 + j;
              const bool ok = dir == 0 ? (k <= q) : (k >= q);
              const float arg = ok ? (cq - ck4[j]) * 1.4426950408889634f : -1.0e30f;
              gv[j] = sc[half][j] * __builtin_amdgcn_exp2f(arg);
            }
            gp.w[half * 2] = pk2(gv[0], gv[1]);
            gp.w[half * 2 + 1] = pk2(gv[2], gv[3]);
          }
#pragma unroll
          for (int pt = 0; pt < 4; ++pt) {
            union { bf16x8 v; uint2 hh[2]; } xf;
            const u16* xs = sXt + dir * 64 * LDX + (pt * 16 + lr) * LDX + u * 32 + lq * 4;
            xf.hh[0] = *(const uint2*)(xs);
            xf.hh[1] = *(const uint2*)(xs + 16);
            acc[dir][pt] = mma16<true>(xf.v, gp.v, acc[dir][pt]);
          }
        }
      }
#pragma unroll
      for (int pt = 0; pt < 4; ++pt) {
        const uint2 xu = *(const uint2*)(XBC + (size_t)(r0 + q) * 1536 + h * 64 + pt * 16 + lq * 4);
        f32x4 y = acc[0][pt] + acc[1][pt];
        y[0] += dsk * bflo(xu.x);
        y[1] += dsk * bfhi(xu.x);
        y[2] += dsk * bflo(xu.y);
        y[3] += dsk * bfhi(xu.y);
        st_bf4(Yssd + (size_t)(r0 + q) * 1024 + h * 64 + pt * 16 + lq * 4, y);
      }
    }
    __syncthreads();
  }
}

DI void phase_ssd_finish(const Params& p, int l, int nrows) {
  u16* Yssd = (u16*)(p.ws + OFF_YSSD);
  const u16* Z = (const u16*)(p.ws + OFF_Z);
  const float* g = p.g_ssd + l * 1024;
  const int lane = TIDX & 63;
  const int gw = (blockIdx.x * 256 + TIDX) >> 6, nw = (gridDim.x * 256) >> 6;
  for (int r = gw; r < nrows; r += nw) {
    float v[16];
    float ss = 0.f;
#pragma unroll
    for (int i = 0; i < 2; ++i) {
      const uint4 yu = *(const uint4*)(Yssd + (size_t)r * 1024 + i * 512 + lane * 8);
      const uint4 zu = *(const uint4*)(Z + (size_t)r * 1024 + i * 512 + lane * 8);
      const unsigned ya[4] = {yu.x, yu.y, yu.z, yu.w}, za[4] = {zu.x, zu.y, zu.z, zu.w};
#pragma unroll
      for (int k = 0; k < 4; ++k) {
        const float a = bflo(ya[k]) * siluf(bflo(za[k])), bb = bfhi(ya[k]) * siluf(bfhi(za[k]));
        v[i * 8 + 2 * k] = a;
        v[i * 8 + 2 * k + 1] = bb;
        ss += a * a + bb * bb;
      }
    }
    const float rstd = rsqrtf(wave_sum(ss) * (1.f / 1024.f) + EPS);
#pragma unroll
    for (int i = 0; i < 2; ++i) {
      const f32x4 g0 = *(const f32x4*)(g + i * 512 + lane * 8), g1 = *(const f32x4*)(g + i * 512 + lane * 8 + 4);
      uint4 o;
      o.x = pk2(v[i * 8 + 0] * rstd * g0[0], v[i * 8 + 1] * rstd * g0[1]);
      o.y = pk2(v[i * 8 + 2] * rstd * g0[2], v[i * 8 + 3] * rstd * g0[3]);
      o.z = pk2(v[i * 8 + 4] * rstd * g1[0], v[i * 8 + 5] * rstd * g1[1]);
      o.w = pk2(v[i * 8 + 6] * rstd * g1[2], v[i * 8 + 7] * rstd * g1[3]);
      *(uint4*)(Yssd + (size_t)r * 1024 + i * 512 + lane * 8) = o;
    }
  }
}

DI void phase_merge(const Params& p, int l, int nrows, const float* srcL, const float* srcC, u16* smem) {
  const u16* H = (const u16*)(p.ws + OFF_H2);
  const u16* W0 = (const u16*)(p.ws + OFF_W0);
  const float* modl = (const float*)(p.ws + OFF_MODV) + (size_t)l * 5 * 6144;
  const float* bg = p.b_gate + l * 3072;
  float* XC = (float*)(p.ws + OFF_XC);
  const int tid = TIDX, lane = tid & 63, wid = tid >> 6, wm = wid >> 1, wn = wid & 1, lr = lane & 15, lq = lane >> 4;
  const int MT = nrows / 128;
  XCD_TILE_LOOP(MT, 8) {
    int mt, nt;
    tile_xcd(j_, blockIdx.x & 7, MT >> 3, 8, mt, nt);
    const int n0 = nt * 128;
#pragma unroll 1
    for (int br = 0; br < 3; ++br) {
      const u16* Ybr = (const u16*)(p.ws + (br == 0 ? OFF_YMLA : (br == 1 ? OFF_YSSD : OFF_YGQA)));
      const int ldyb = br == 1 ? 1024 : 512, koffb = br == 0 ? 0 : (br == 1 ? 512 : 1536);
      f32x4 gt[4][4];
      zero_acc<4>(gt);
      gemm_core<4>(H + (size_t)mt * 128 * 1024, 1024, W0 + (size_t)(br * 1024 + n0) * 1024, 1024, 1024, gt, smem);
      uint2 gp[4][4];
#pragma unroll
      for (int ni = 0; ni < 4; ++ni) {
        const f32x4 bv = *(const f32x4*)(bg + br * 1024 + n0 + wn * 64 + ni * 16 + lq * 4);
#pragma unroll
        for (int mi = 0; mi < 4; ++mi) {
          gp[mi][ni].x = pk2(sigmf(gt[mi][ni][0] + bv[0]), sigmf(gt[mi][ni][1] + bv[1]));
          gp[mi][ni].y = pk2(sigmf(gt[mi][ni][2] + bv[2]), sigmf(gt[mi][ni][3] + bv[3]));
          asm volatile("" : "+v"(gp[mi][ni].x), "+v"(gp[mi][ni].y));
        }
      }
      f32x4 ya[4][4];
      zero_acc<4>(ya);
      gemm_core<4>(Ybr + (size_t)mt * 128 * ldyb, ldyb, W0 + W0_OUT + (size_t)n0 * 2048 + koffb, 2048, ldyb, ya, smem);
#pragma unroll
      for (int mi = 0; mi < 4; ++mi) {
        const int row = mt * 128 + wm * 64 + mi * 16 + lr;
        const float* src = row < TL ? srcL + (size_t)row * D : srcC + (size_t)(row - TL) * D;
        float* dst = row < TL ? p.out + (size_t)row * D : XC + (size_t)(row - TL) * D;
        const float* g1 = modl + row_mod(row) * 6144 + 2048;
#pragma unroll
        for (int ni = 0; ni < 4; ++ni) {
          const int col = n0 + wn * 64 + ni * 16 + lq * 4;
          const f32x4 gv = *(const f32x4*)(g1 + col);
          f32x4 base;
          if (br == 0) base = ALPHA * *(const f32x4*)(src + col);
          else base = *(const f32x4*)(dst + col);
          f32x4 gf;
          gf[0] = bflo(gp[mi][ni].x); gf[1] = bfhi(gp[mi][ni].x); gf[2] = bflo(gp[mi][ni].y); gf[3] = bfhi(gp[mi][ni].y);
          *(f32x4*)(dst + col) = base + gv * (gf * ya[mi][ni]);
        }
        __builtin_amdgcn_sched_barrier(0);
      }
    }
  }
}

DI void phase_ffn_in(const Params& p, int nrows, u16* smem) {
  const u16* H = (const u16*)(p.ws + OFF_H2);
  const u16* W0 = (const u16*)(p.ws + OFF_W0);
  u16* ACT = (u16*)(p.ws + OFF_ACT);
  const int tid = TIDX, lane = tid & 63, wid = tid >> 6, wm = wid >> 1, wn = wid & 1, lr = lane & 15, lq = lane >> 4;
  const int MT = nrows / 128;
  XCD_TILE_LOOP(MT, 44) {
    int mt, nt;
    tile_xcd(j_, blockIdx.x & 7, MT >> 3, 44, mt, nt);
    f32x4 acc[4][4];
    zero_acc<4>(acc);
    gemm_core<4, true>(H + (size_t)mt * 128 * 1024, 1024, W0 + (size_t)nt * 128 * 1024, 1024, 1024, acc, smem);
#pragma unroll
    for (int mi = 0; mi < 4; ++mi) {
      const int row = mt * 128 + wm * 64 + mi * 16 + lr;
#pragma unroll
      for (int pr = 0; pr < 2; ++pr) {
        const int q = (nt * 128 + wn * 64 + pr * 32) >> 5;
        f32x4 v;
#pragma unroll
        for (int j = 0; j < 4; ++j) v[j] = siluf(acc[mi][2 * pr][j]) * acc[mi][2 * pr + 1][j];
        st_h4(ACT + (size_t)row * FFN_H + q * 16 + lq * 4, v);
      }
    }
  }
}

DI void phase_ffn_out(const Params& p, int l, int nrows, u16* smem) {
  const u16* ACT = (const u16*)(p.ws + OFF_ACT);
  const u16* W1 = (const u16*)(p.ws + OFF_W1);
  const float* modl = (const float*)(p.ws + OFF_MODV) + (size_t)l * 5 * 6144;
  float* XC = (float*)(p.ws + OFF_XC);
  const int tid = TIDX, lane = tid & 63, wid = tid >> 6, wm = wid >> 1, wn = wid & 1, lr = lane & 15, lq = lane >> 4;
  const int MT = nrows / 128;
  XCD_TILE_LOOP(MT, 8) {
    int mt, nt;
    tile_xcd(j_, blockIdx.x & 7, MT >> 3, 8, mt, nt);
    f32x4 acc[4][4];
    zero_acc<4>(acc);
    gemm_core<4, true>(ACT + (size_t)mt * 128 * FFN_H, FFN_H, W1 + (size_t)nt * 128 * FFN_H, FFN_H, FFN_H, acc, smem);
#pragma unroll
    for (int mi = 0; mi < 4; ++mi) {
      const int row = mt * 128 + wm * 64 + mi * 16 + lr;
      float* xp = row < TL ? p.out + (size_t)row * D : XC + (size_t)(row - TL) * D;
      const float* g2 = modl + row_mod(row) * 6144 + 5120;
#pragma unroll
      for (int ni = 0; ni < 4; ++ni) {
        const int col = nt * 128 + wn * 64 + ni * 16 + lq * 4;
        const f32x4 xv = *(const f32x4*)(xp + col), gv = *(const f32x4*)(g2 + col);
        *(f32x4*)(xp + col) = ALPHA * xv + gv * acc[mi][ni];
      }
    }
  }
}

#define XB_TMO      128
#define XB_XCNT(j)  (256  + 64 * (j))
#define XB_XSUB(j)  (1280 + 64 * (j))
#define XB_XGEN(j)  (2304 + 64 * (j))
#define XB_TOP      3328
#define XB_TOPGEN   3392
#define XCD_BAR_WORDS 3456
#define XB_SPIN_CAP (1u << 20)
#define LAS __attribute__((address_space(3)))
DI unsigned xb_ld(unsigned* p) { return __hip_atomic_load(p, __ATOMIC_RELAXED, __HIP_MEMORY_SCOPE_AGENT); }
DI unsigned xb_add(unsigned* p, unsigned v) { return __hip_atomic_fetch_add(p, v, __ATOMIC_RELAXED, __HIP_MEMORY_SCOPE_AGENT); }
DI unsigned xb_xcc_id() { return (unsigned)__builtin_amdgcn_s_getreg((3 << 11) | 20) & 0xFu; }
#define XB_SPIN(cond, bar) do { unsigned _sp = 0; while (cond) { __builtin_amdgcn_s_sleep(1); \
    if ((++_sp & 255u) == 0u) { if (xb_ld(&(bar)[XB_TMO])) break; if (_sp > XB_SPIN_CAP) { atomicAdd(&(bar)[XB_TMO], 1u); break; } } } } while (0)
struct XcdBarrier { unsigned* bar; unsigned x; volatile LAS unsigned* st; };
DI XcdBarrier xcd_barrier_post(unsigned* bar, volatile LAS unsigned* st) {
  XcdBarrier b; b.bar = bar; b.x = xb_xcc_id(); b.st = st;
  if (threadIdx.x == 0) (void)xb_add(&bar[XB_XCNT(b.x)], 1u);
  return b;
}
DI void xcd_barrier_complete(unsigned* bar, unsigned x, unsigned& nloc, unsigned& nx) {
  const unsigned G = gridDim.x * gridDim.y * gridDim.z;
  unsigned sum, cnt, mine, sp = 0u;
  for (;;) {
    sum = 0u; cnt = 0u; mine = 0u;
#pragma unroll
    for (unsigned j = 0; j < 16; ++j) { const unsigned c = xb_ld(&bar[XB_XCNT(j)]); sum += c; cnt += (c > 0u) ? 1u : 0u; mine = (j == x) ? c : mine; }
    if (sum == G) break;
    __builtin_amdgcn_s_sleep(1);
    if ((++sp & 255u) == 0u) { if (xb_ld(&bar[XB_TMO])) break; if (sp > XB_SPIN_CAP) { atomicAdd(&bar[XB_TMO], 1u); break; } }
  }
  nloc = mine > 0u ? mine : 1u; nx = cnt > 0u ? cnt : 1u;
}
DI void xcd_barrier(const XcdBarrier& b) {
  asm volatile("s_waitcnt vmcnt(0)" ::: "memory");
  __syncthreads();
  if (threadIdx.x == 0) {
    unsigned* bar = b.bar;
    __builtin_amdgcn_s_waitcnt(0);
    unsigned nloc = b.st[0], nx = b.st[1];
    if (nloc == 0u) { xcd_barrier_complete(bar, b.x, nloc, nx); b.st[0] = nloc; b.st[1] = nx; }
    const unsigned old = xb_add(&bar[XB_XSUB(b.x)], 1u);
    const unsigned gen = old / nloc;
    if (old + 1u == (gen + 1u) * nloc) {
      __builtin_amdgcn_fence(__ATOMIC_RELEASE, "agent");
      asm volatile("s_waitcnt vmcnt(0)" ::: "memory");
      const unsigned og = xb_add(&bar[XB_TOP], 1u);
      const unsigned tg = og / nx;
      if (og + 1u == (tg + 1u) * nx) xb_add(&bar[XB_TOPGEN], 1u);
      else XB_SPIN(xb_ld(&bar[XB_TOPGEN]) == tg, bar);
      __builtin_amdgcn_fence(__ATOMIC_ACQUIRE, "agent");
      xb_add(&bar[XB_XGEN(b.x)], 1u);
      asm volatile("s_waitcnt vmcnt(0)" ::: "memory");
    } else {
      XB_SPIN(xb_ld(&bar[XB_XGEN(b.x)]) == gen, bar);
      __builtin_amdgcn_fence(__ATOMIC_ACQUIRE, "agent");
      asm volatile("s_waitcnt vmcnt(0)" ::: "memory");
    }
  }
  __syncthreads();
}

constexpr int NPHASE = 2 + 13 * 2;

__global__ void __launch_bounds__(256, 2) fwd_megakernel(Params p) {
  __shared__ __attribute__((aligned(16))) unsigned char smem_raw[SMEM_BYTES];
  u16* smem = (u16*)smem_raw;
  float* smf = (float*)smem_raw;
  cg::grid_group grid = cg::this_grid();
  __shared__ uint4 xb_words;
  if (threadIdx.x == 0) xb_words = make_uint4(0u, 0u, 0u, 0u);
  __syncthreads();
  XcdBarrier xb = xcd_barrier_post((unsigned*)(p.ws + OFF_BAR), (volatile LAS unsigned*)&xb_words);
  if (p.ph0 < 0) grid.sync();
  const float* modv = (const float*)(p.ws + OFF_MODV);
  float* XC = (float*)(p.ws + OFF_XC);
  for (int ph = p.ph0; ph < p.ph1; ++ph) {
    if (ph == 0) {
      phase_prologue(p, smf);
      cvt_inproj_set(p, 0, smf);
    } else if (ph == 1) {
      ln_rows<0>(p, T, p.x, p.ctx, nullptr, nullptr, nullptr, nullptr, modv, 0, 1024, (u16*)(p.ws + OFF_H), true);
    } else {
      const int l = (ph - 2) / 13, s = (ph - 2) % 13;
      const bool with_ctx = (l == 0);
      const int nrows = with_ctx ? T : TL;
      const float* modl = modv + (size_t)l * 5 * 6144;
      const float* srcL = (l == 0) ? p.x : p.out;
      const float* srcC = (l == 0) ? p.ctx : XC;
      switch (s) {
        case 0: phase_inproj(p, l, smem); break;
        case 1: phase_c1(p, l); break;
        case 2: phase_c2(p, l, smem); break;
        case 3: phase_attn(p, l, with_ctx, smem); break;
        case 4: phase_ssd_states(p, l, smem); break;
        case 5: phase_ssd_scan(p); cvt_merge_set(p, l, smf); break;
        case 6: phase_ssd_y(p, l, with_ctx, smem); break;
        case 7:
          phase_ssd_finish(p, l, nrows);
          ln_rows<0>(p, nrows, srcL, srcC, nullptr, nullptr, nullptr, nullptr, modl, 0, 1024, (u16*)(p.ws + OFF_H2), true);
          break;
        case 8: phase_merge(p, l, nrows, srcL, srcC, smem); break;
        case 9:
          ln_rows<1>(p, nrows, p.out, XC, p.out, XC, p.ln1_g + l * D, p.ln1_b + l * D, modl, 3072, 4096, (u16*)(p.ws + OFF_H2), true, true);
          cvt_ffn_set(p, l, smf);
          break;
        case 10: phase_ffn_in(p, nrows, smem); break;
        case 11: phase_ffn_out(p, l, nrows, smem); break;
        case 12:
          if (l == 0) {
            ln_rows<1>(p, nrows, p.out, XC, p.out, XC, p.ln2_g + l * D, p.ln2_b + l * D, modv + (size_t)5 * 6144, 0, 1024, (u16*)(p.ws + OFF_H), true);
            cvt_inproj_set(p, 1, smf);
          } else {
            ln_rows<1>(p, nrows, p.out, XC, p.out, XC, p.ln2_g + l * D, p.ln2_b + l * D, modl, 0, 1024, nullptr, false);
          }
          break;
      }
    }
    if (ph + 1 < p.ph1) xcd_barrier(xb);
  }
#ifdef DBG_N
  grid.sync();
  {
    const u16* w16 = (const u16*)p.ws;
    const size_t n16 = WS_END / 2;
    const int gtid = blockIdx.x * 256 + TIDX, gn = gridDim.x * 256;
    for (int i = gtid; i < TL * D; i += gn) {
      unsigned s = 0;
      for (int j = 0; j < 8; ++j) {
        const size_t a = (size_t)i + (size_t)j * (size_t)(TL * D);
        if (a < n16) s += w16[a] * (unsigned)(j + 1);
      }
      p.out[i] = (float)(s & 0xFFFFFu);
    }
  }
#endif
}

extern "C" void kernel_launch(void* const* d_in, const int* in_sizes, int n_in, void* d_out, int out_size, void* d_ws,
                              size_t ws_size, hipStream_t stream) {
  static int grid_blocks = 0;
  if (!grid_blocks) {
    int dev = 0, cus = 0, per_cu = 0;
    (void)hipGetDevice(&dev);
    (void)hipDeviceGetAttribute(&cus, hipDeviceAttributeMultiprocessorCount, dev);
    (void)hipOccupancyMaxActiveBlocksPerMultiprocessor(&per_cu, fwd_megakernel, 256, 0);
    if (per_cu > 2) per_cu = 2;
    if (per_cu < 1) per_cu = 1;
    grid_blocks = cus * per_cu;
  }
  if (n_in != 27 || ws_size < WS_TOTAL || out_size != TL * D) {
    fprintf(stderr, "kernel_launch: unexpected shapes (n_in %d, out %d, ws %zu < %zu)\n", n_in, out_size, ws_size, (size_t)WS_END);
    return;
  }
  Params p{};
  const float** pp = (const float**)&p;
  for (int i = 0; i < 27; ++i) pp[i] = (const float*)d_in[i];
  p.out = (float*)d_out;
  p.ws = (char*)d_ws;
  p.ph0 = 0;
#ifdef DBG_N
  p.ph1 = DBG_N;
#else
  p.ph1 = NPHASE;
#endif
  (void)hipMemsetAsync((char*)d_ws + OFF_BAR, 0, XCD_BAR_WORDS * 4, stream);
  void* args[] = {&p};
  hipError_t e = hipLaunchCooperativeKernel((void*)fwd_megakernel, dim3(grid_blocks), dim3(256), args, 0, stream);
  if (e != hipSuccess) fprintf(stderr, "cooperative launch failed: %s (grid %d)\n", hipGetErrorString(e), grid_blocks);
}
```

```cpp
#include <hip/hip_runtime.h>
#include <hip/hip_cooperative_groups.h>
#include <cstdio>
namespace cg = cooperative_groups;

typedef unsigned short u16;
typedef __attribute__((ext_vector_type(8))) short bf16x8;
typedef __attribute__((ext_vector_type(4))) float f32x4;
#define DI __device__ __forceinline__

constexpr int D = 1024, NBATCH = 4, SEQ = 4096, CTXL = 256;
constexpr int TL = NBATCH * SEQ, TC = NBATCH * CTXL, T = TL + TC;
constexpr int NKEY = CTXL + SEQ;
constexpr int NCH = 34;
constexpr int IN_W = 7104, FFN_H = 2816;
constexpr int WINP = 4224;
constexpr float EPS = 1e-6f;
constexpr float ALPHA = 1.41421356237f;

constexpr size_t OFF_MODV = 0;
constexpr size_t OFF_COSM = OFF_MODV + 2 * 5 * 6144 * 4;
constexpr size_t OFF_SINM = OFF_COSM + 4096 * 16 * 4;
constexpr size_t OFF_COSG = OFF_SINM + 4096 * 16 * 4;
constexpr size_t OFF_SING = OFF_COSG + 4096 * 32 * 4;
constexpr size_t OFF_STATS = OFF_SING + 4096 * 32 * 4;
constexpr size_t OFF_CHDEC = OFF_STATS + (size_t)T * 2 * 4;
constexpr size_t OFF_XC = OFF_CHDEC + 2 * 4 * 34 * 16 * 4;
constexpr size_t OFF_W0 = OFF_XC + (size_t)TC * D * 4;
constexpr size_t OFF_W1 = OFF_W0 + (size_t)5632 * 1024 * 2;
constexpr size_t OFF_VTG = OFF_W1 + (size_t)1024 * 2816 * 2;
constexpr size_t OFF_R0 = OFF_VTG + (size_t)4 * 2 * 64 * NKEY * 2;
constexpr size_t SZ_T1024 = (size_t)T * 1024 * 2;
constexpr size_t SZ_XBC = (size_t)T * 1536 * 2;
constexpr size_t OFF_R1 = OFF_R0 + SZ_T1024 + SZ_XBC;
constexpr size_t OFF_R2 = OFF_R1 + SZ_T1024;
constexpr size_t OFF_R3 = OFF_R2 + SZ_XBC;
constexpr size_t OFF_R4 = OFF_R3 + (size_t)T * 32 * 4;
constexpr size_t OFF_BAR = OFF_R4 + SZ_XBC;
constexpr size_t WS_END = OFF_R4 + SZ_XBC;
constexpr size_t WS_TOTAL = OFF_BAR + 16384;
constexpr size_t OFF_H = OFF_R0;
constexpr size_t OFF_XR = OFF_R0 + SZ_T1024;
constexpr size_t OFF_QM = OFF_R0;
constexpr size_t OFF_KM = OFF_QM + (size_t)T * 768 * 2;
constexpr size_t OFF_VTM = OFF_KM + (size_t)T * 768 * 2;
constexpr size_t OFF_YMLA = OFF_VTM + (size_t)T * 512 * 2;
constexpr size_t OFF_S = OFF_R0;
constexpr size_t OFF_ACT = OFF_R0;
constexpr size_t OFF_Z = OFF_R1;
constexpr size_t OFF_XBC = OFF_R2;
constexpr size_t OFF_H2 = OFF_R2;
constexpr size_t OFF_DT = OFF_R3;
constexpr size_t OFF_PGQA = OFF_R4;
constexpr size_t OFF_PMLA = OFF_R4 + (size_t)T * 640 * 2;
constexpr size_t OFF_YGQA = OFF_R4 + SZ_T1024;
constexpr size_t OFF_YSSD = OFF_R4;
static_assert(OFF_YMLA + (size_t)T * 512 * 2 == OFF_R1, "R0 layout");
static_assert(OFF_PMLA + (size_t)T * 672 * 2 <= WS_END, "R4 layout");
static_assert(OFF_YGQA + (size_t)T * 512 * 2 == WS_END, "R4 layout");
static_assert((size_t)2 * 4 * 34 * 16 * 64 * 128 * 2 <= (size_t)T * (768 + 768 + 512) * 2, "S fits");
static_assert(OFF_ACT + (size_t)T * 2816 * 2 <= OFF_R2, "ACT fits");
constexpr size_t W0_UQ = (size_t)WINP * 1024;
constexpr size_t W0_UKV = W0_UQ + (size_t)768 * 384;
constexpr size_t W0_OUT = (size_t)3072 * 1024;

constexpr int SMEM_BYTES = 73728;

struct Params {
  const float *x, *c, *ctx, *c_ctx, *w_mod, *b_mod, *w_in, *b_gate, *w_uq, *g_q_mla, *w_ukv, *g_kv_mla, *conv_w,
      *conv_b, *a_log, *dt_bias, *d_skip, *g_ssd, *g_q_gqa, *g_k_gqa, *w_out, *ln1_g, *ln1_b, *w_ffn_in, *w_ffn_out,
      *ln2_g, *ln2_b;
  float* out;
  char* ws;
  int ph0, ph1;
};

DI int threadIdx_x_raw() { return (int)__builtin_amdgcn_workitem_id_x(); }
DI int opaque_tid() { int t = threadIdx_x_raw(); asm volatile("" : "+v"(t)); return t; }
#define TIDX opaque_tid()
typedef _Float16 f16x2_t __attribute__((ext_vector_type(2)));
typedef _Float16 f16x8_t __attribute__((ext_vector_type(8)));
DI float bflo(unsigned w) { return (float)__builtin_bit_cast(f16x2_t, w)[0]; }
DI float bfhi(unsigned w) { return (float)__builtin_bit_cast(f16x2_t, w)[1]; }
DI float bf2f(u16 h) { return bflo((unsigned)h); }
typedef __bf16 bf16x2_t __attribute__((ext_vector_type(2)));
typedef float f32x2_t __attribute__((ext_vector_type(2)));
DI unsigned pk2(float lo, float hi) {
  f32x2_t f = {lo, hi};
  f16x2_t b = __builtin_convertvector(f, f16x2_t);
  return __builtin_bit_cast(unsigned, b);
}
DI u16 f2bf(float f) { return (u16)(pk2(f, 0.f) & 0xffffu); }
DI unsigned pkh2(float lo, float hi) {
  f32x2_t f = {lo, hi};
  f16x2_t b = __builtin_convertvector(f, f16x2_t);
  return __builtin_bit_cast(unsigned, b);
}
DI u16 f2h(float f) { return (u16)(pkh2(f, 0.f) & 0xffffu); }
DI float siluf(float x) { return x / (1.f + __expf(-x)); }
DI float sigmf(float x) { return 1.f / (1.f + __expf(-x)); }
DI void st_bf4(u16* p, f32x4 v) {
  uint2 u;
  u.x = pk2(v[0], v[1]);
  u.y = pk2(v[2], v[3]);
  *(uint2*)p = u;
}
DI void st_h4(u16* p, f32x4 v) {
  uint2 u;
  u.x = pkh2(v[0], v[1]);
  u.y = pkh2(v[2], v[3]);
  *(uint2*)p = u;
}
template <bool F16>
DI f32x4 mma16(bf16x8 a, bf16x8 b, f32x4 c) {
  return __builtin_amdgcn_mfma_f32_16x16x32_f16(__builtin_bit_cast(f16x8_t, a), __builtin_bit_cast(f16x8_t, b), c, 0, 0, 0);
}
DI int row_mod(int r) { return r < TL ? (r >> 12) : 4; }
DI int row_batch(int r) { return r < TL ? (r >> 12) : ((r - TL) >> 8); }
DI int row_key(int r) { return r < TL ? CTXL + (r & 4095) : ((r - TL) & 255); }
DI float quad_max(float v) {
  auto r = __builtin_amdgcn_permlane16_swap(__float_as_uint(v), __float_as_uint(v), false, false);
  v = fmaxf(__uint_as_float(r[0]), __uint_as_float(r[1]));
  auto s = __builtin_amdgcn_permlane32_swap(__float_as_uint(v), __float_as_uint(v), false, false);
  return fmaxf(__uint_as_float(s[0]), __uint_as_float(s[1]));
}
DI float quad_sum(float v) {
  auto r = __builtin_amdgcn_permlane16_swap(__float_as_uint(v), __float_as_uint(v), false, false);
  v = __uint_as_float(r[0]) + __uint_as_float(r[1]);
  auto s = __builtin_amdgcn_permlane32_swap(__float_as_uint(v), __float_as_uint(v), false, false);
  return __uint_as_float(s[0]) + __uint_as_float(s[1]);
}
DI float wave_sum(float v) {
#pragma unroll
  for (int o = 32; o > 0; o >>= 1) v += __shfl_xor(v, o);
  return v;
}

#define GAS __attribute__((address_space(1)))
#define LAS3 __attribute__((address_space(3)))
template <int NI, bool F16 = false>
DI void gemm_core(const u16* __restrict__ A, int lda, const u16* __restrict__ B, int ldb, int K, f32x4 (&acc)[4][NI],
                  u16* smem) {
  constexpr int BN = 32 * NI;
  constexpr int NBL = BN / 32;
  char* sA = (char*)smem;
  char* sB = sA + 2 * 16384;
  const int tid = TIDX, lane = tid & 63, wid = tid >> 6, wm = wid >> 1, wn = wid & 1;
  const int lr = lane & 15, lq = lane >> 4;
  const int r8 = tid >> 3, gc = (tid & 7) ^ (r8 & 7);
  const int wq = __builtin_amdgcn_readfirstlane(wid) * 1024;
  const u16* Ap = A + (size_t)r8 * lda + gc * 8;
  const u16* Bp = B + (size_t)r8 * ldb + gc * 8;
  const int nk = K >> 6;
#define GEMM_ISSUE(KT, BUF)                                                                                         \
  {                                                                                                                 \
    const int ko_ = (KT) * 64;                                                                                      \
    _Pragma("unroll") for (int i = 0; i < 4; ++i)                                                                   \
        __builtin_amdgcn_global_load_lds((const GAS unsigned*)(Ap + (size_t)(32 * i) * lda + ko_),                  \
                                         (LAS3 unsigned*)(sA + (BUF) * 16384 + i * 4096 + wq), 16, 0, 0);           \
    _Pragma("unroll") for (int i = 0; i < NBL; ++i)                                                                 \
        __builtin_amdgcn_global_load_lds((const GAS unsigned*)(Bp + (size_t)(32 * i) * ldb + ko_),                  \
                                         (LAS3 unsigned*)(sB + (BUF) * (BN * 128) + i * 4096 + wq), 16, 0, 0);       \
  }
  GEMM_ISSUE(0, 0)
  asm volatile("s_waitcnt vmcnt(0)" ::: "memory");
  __builtin_amdgcn_s_barrier();
  const int x0 = ((0 + lq) ^ (lr & 7)) << 4, x1 = ((4 + lq) ^ (lr & 7)) << 4;
  const unsigned la = (unsigned)(size_t)((LAS3 char*)(sA + (wm * 64 + lr) * 128));
  const unsigned lb = (unsigned)(size_t)((LAS3 char*)(sB + (wn * 16 * NI + lr) * 128));
  const unsigned la0 = la + x0, la1 = la + x1, lb0 = lb + x0, lb1 = lb + x1;
#define LDSR(dst, addr, off) asm volatile("ds_read_b128 %0, %1 offset:%2" : "=v"(dst) : "v"(addr), "n"(off))
#define GEMM_HALF(BUF, LA, LB)                                                                             \
  {                                                                                                        \
    bf16x8 a0[4], b0[NI];                                                                                  \
    LDSR(a0[0], LA, (BUF) * 16384 + 0 * 2048); LDSR(a0[1], LA, (BUF) * 16384 + 1 * 2048);                  \
    LDSR(a0[2], LA, (BUF) * 16384 + 2 * 2048); LDSR(a0[3], LA, (BUF) * 16384 + 3 * 2048);                  \
    LDSR(b0[0], LB, (BUF) * (BN * 128) + 0 * 2048); LDSR(b0[1], LB, (BUF) * (BN * 128) + 1 * 2048);        \
    if (NI == 4) { LDSR(b0[NI - 2], LB, (BUF) * (BN * 128) + 2 * 2048); LDSR(b0[NI - 1], LB, (BUF) * (BN * 128) + 3 * 2048); } \
    if (NI == 4) asm volatile("s_waitcnt lgkmcnt(0)" : "+v"(a0[0]), "+v"(a0[1]), "+v"(a0[2]), "+v"(a0[3]), "+v"(b0[0]), "+v"(b0[1]), "+v"(b0[NI - 2]), "+v"(b0[NI - 1])); \
    else asm volatile("s_waitcnt lgkmcnt(0)" : "+v"(a0[0]), "+v"(a0[1]), "+v"(a0[2]), "+v"(a0[3]), "+v"(b0[0]), "+v"(b0[1])); \
    _Pragma("unroll") for (int mi = 0; mi < 4; ++mi)                                                       \
        _Pragma("unroll") for (int ni = 0; ni < NI; ++ni)                                                  \
            acc[mi][ni] = mma16<F16>(b0[ni], a0[mi], acc[mi][ni]);                                         \
  }
#define GEMM_COMPUTE(BUF) GEMM_HALF(BUF, la0, lb0) GEMM_HALF(BUF, la1, lb1)
  for (int kt = 0; kt < nk; kt += 2) {
    GEMM_ISSUE(kt + 1, 1)
    GEMM_COMPUTE(0)
    asm volatile("s_waitcnt vmcnt(0)" ::: "memory");
    __builtin_amdgcn_s_barrier();
    if (kt + 2 < nk) GEMM_ISSUE(kt + 2, 0)
    GEMM_COMPUTE(1)
    asm volatile("s_waitcnt vmcnt(0)" ::: "memory");
    __builtin_amdgcn_s_barrier();
  }
#undef GEMM_COMPUTE
#undef GEMM_HALF
#undef LDSR
#undef GEMM_ISSUE
}

template <int NI>
DI void zero_acc(f32x4 (&acc)[4][NI]) {
#pragma unroll
  for (int i = 0; i < 4; ++i)
#pragma unroll
    for (int j = 0; j < NI; ++j) acc[i][j] = (f32x4){0.f, 0.f, 0.f, 0.f};
}

DI void tile_xcd(int j, int x, int mc, int NT, int& mt, int& nt) {
  const int h0 = (mc + 3) >> 2;
  const int per = h0 * NT, blk = j / per, rem = j - blk * per;
  const int hb = (mc - blk * h0) < h0 ? (mc - blk * h0) : h0;
  const int ml = blk * h0 + rem % hb;
  nt = rem / hb;
  mt = ml * 8 + x;
}
#define XCD_TILE_LOOP(MT_, NT_) for (int j_ = blockIdx.x >> 3; j_ < ((MT_) >> 3) * (NT_); j_ += gridDim.x >> 3)
DI void tile_mn(int t, int MT, int NT, int& mt, int& nt) {
  const int per = 16 * NT;
  const int grp = t / per, rem = t - grp * per;
  const int gsz = (MT - grp * 16) < 16 ? (MT - grp * 16) : 16;
  mt = grp * 16 + rem % gsz;
  nt = rem / gsz;
}

struct MapIdent { int base; DI int operator()(int r) const { return base + r; } };
struct MapInproj {
  DI int operator()(int r) const {
    if (r < 768) return r < 672 ? r : -1;
    if (r < 1792) return 672 + (r - 768);
    if (r < 3328) return 1696 + (r - 1792);
    if (r < 3456) return (r - 3328) < 32 ? 3232 + (r - 3328) : -1;
    return 3264 + (r - 3456);
  }
};
struct MapFfnIn {
  DI int operator()(int r) const {
    const int q = r >> 5, s = r & 31;
    return s < 16 ? 16 * q + s : FFN_H + 16 * q + (s - 16);
  }
};
template <class Map, bool F16 = false>
DI void cvt_tile(const float* __restrict__ src, int ldsrc, u16* __restrict__ dst, int K, int r0, int k0,
                 const float* kscale, Map map, float* tile) {
  const int tid = TIDX;
  {
    const int rl = tid & 63;
    const int sc = map(r0 + rl);
#pragma unroll 4
    for (int i = 0; i < 16; ++i) {
      const int kl = (tid >> 6) + 4 * i;
      tile[kl * 65 + rl] = sc >= 0 ? src[(size_t)(k0 + kl) * ldsrc + sc] : 0.f;
    }
  }
  __syncthreads();
  {
    const int kl = tid & 63;
    const float s = kscale ? kscale[k0 + kl] : 1.f;
#pragma unroll 4
    for (int i = 0; i < 16; ++i) {
      const int rl = (tid >> 6) + 4 * i;
      dst[(size_t)(r0 + rl) * K + k0 + kl] = F16 ? f2h(tile[kl * 65 + rl] * s) : f2bf(tile[kl * 65 + rl] * s);
    }
  }
  __syncthreads();
}
DI void cvt_inproj_set(const Params& p, int l, float* tile) {
  u16* W0 = (u16*)(p.ws + OFF_W0);
  constexpr int N1 = (WINP / 64) * 16, N2 = (768 / 64) * (384 / 64), N3 = (1024 / 64) * (256 / 64);
  for (int it = blockIdx.x; it < N1 + N2 + N3; it += gridDim.x) {
    if (it < N1) {
      cvt_tile(p.w_in + (size_t)l * 1024 * IN_W, IN_W, W0, 1024, (it >> 4) * 64, (it & 15) * 64, nullptr, MapInproj(), tile);
    } else if (it < N1 + N2) {
      const int j = it - N1;
      cvt_tile(p.w_uq + (size_t)l * 384 * 768, 768, W0 + W0_UQ, 384, (j / 6) * 64, (j % 6) * 64, p.g_q_mla + l * 384, MapIdent{0}, tile);
    } else {
      const int j = it - N1 - N2;
      cvt_tile(p.w_ukv + (size_t)l * 256 * 1024, 1024, W0 + W0_UKV, 256, (j >> 2) * 64, (j & 3) * 64, p.g_kv_mla + l * 256, MapIdent{0}, tile);
    }
  }
}
DI void cvt_merge_set(const Params& p, int l, float* tile) {
  u16* W0 = (u16*)(p.ws + OFF_W0);
  constexpr int N1 = (3072 / 64) * 16, N2 = (1024 / 64) * (2048 / 64);
  for (int it = blockIdx.x; it < N1 + N2; it += gridDim.x) {
    if (it < N1) {
      cvt_tile(p.w_in + (size_t)l * 1024 * IN_W, IN_W, W0, 1024, (it >> 4) * 64, (it & 15) * 64, nullptr, MapIdent{4032}, tile);
    } else {
      const int j = it - N1;
      cvt_tile(p.w_out + (size_t)l * 2048 * 1024, 1024, W0 + W0_OUT, 2048, (j >> 5) * 64, (j & 31) * 64, nullptr, MapIdent{0}, tile);
    }
  }
}
DI void cvt_ffn_set(const Params& p, int l, float* tile) {
  u16* W0 = (u16*)(p.ws + OFF_W0);
  u16* W1 = (u16*)(p.ws + OFF_W1);
  constexpr int N1 = (5632 / 64) * 16, N2 = (1024 / 64) * (2816 / 64);
  for (int it = blockIdx.x; it < N1 + N2; it += gridDim.x) {
    if (it < N1) {
      cvt_tile<MapFfnIn, true>(p.w_ffn_in + (size_t)l * 1024 * 5632, 5632, W0, 1024, (it >> 4) * 64, (it & 15) * 64, nullptr, MapFfnIn(), tile);
    } else {
      const int j = it - N1;
      cvt_tile<MapIdent, true>(p.w_ffn_out + (size_t)l * 2816 * 1024, 1024, W1, 2816, (j / 44) * 64, (j % 44) * 64, nullptr, MapIdent{0}, tile);
    }
  }
}

DI void phase_prologue(const Params& p, float* smf) {
  const int tid = TIDX;
  float* sc = smf;
  float* red = smf + 5 * 1024;
  for (int i = tid; i < 5 * 1024; i += 256) {
    const int r = i >> 10, k = i & 1023;
    const float v = r < 4 ? p.c[r * 1024 + k] : p.c_ctx[k];
    sc[i] = siluf(v);
  }
  __syncthreads();
  float* modv = (float*)(p.ws + OFF_MODV);
  for (int it = blockIdx.x; it < 2 * 192; it += gridDim.x) {
    const int l = it / 192, n0 = (it % 192) * 32;
    const int col = tid & 31, kg = tid >> 5;
    float a[5] = {0.f, 0.f, 0.f, 0.f, 0.f};
    const float* w = p.w_mod + (size_t)l * 1024 * 6144 + n0 + col;
    for (int k = kg * 128; k < kg * 128 + 128; ++k) {
      const float wv = w[(size_t)k * 6144];
#pragma unroll
      for (int r = 0; r < 5; ++r) a[r] += sc[r * 1024 + k] * wv;
    }
#pragma unroll
    for (int r = 0; r < 5; ++r) red[(kg * 5 + r) * 32 + col] = a[r];
    __syncthreads();
    if (tid < 160) {
      const int r = tid >> 5, cl = tid & 31;
      float s = p.b_mod[l * 6144 + n0 + cl];
#pragma unroll
      for (int g = 0; g < 8; ++g) s += red[(g * 5 + r) * 32 + cl];
      modv[(l * 5 + r) * 6144 + n0 + cl] = s;
    }
    __syncthreads();
  }
  float* cosM = (float*)(p.ws + OFF_COSM);
  float* sinM = (float*)(p.ws + OFF_SINM);
  float* cosG = (float*)(p.ws + OFF_COSG);
  float* sinG = (float*)(p.ws + OFF_SING);
  const int gtid = blockIdx.x * 256 + tid, gn = gridDim.x * 256;
  for (int i = gtid; i < 4096 * 48; i += gn) {
    const int pos = i / 48, j = i % 48;
    const int prow = pos >> 6, pcol = pos & 63;
    float ang;
    if (j < 16) {
      const int f = j & 7;
      const float inv = exp2f(-(float)f * (13.287712379549449f / 8.f));
      ang = (float)(j < 8 ? prow : pcol) * inv;
    } else {
      const int jj = j - 16, f = jj & 15;
      const float inv = exp2f(-(float)f * (13.287712379549449f / 16.f));
      ang = (float)(jj < 16 ? prow : pcol) * inv;
    }
    float rev = ang * 0.15915494309189535f;
    rev -= floorf(rev);
    const float sn = __builtin_amdgcn_sinf(rev), cs = __builtin_amdgcn_cosf(rev);
    if (j < 16) { cosM[pos * 16 + j] = cs; sinM[pos * 16 + j] = sn; }
    else { cosG[pos * 32 + j - 16] = cs; sinG[pos * 32 + j - 16] = sn; }
  }
}

template <int MODE>
DI void ln_rows(const Params& p, int nrows, const float* srcL, const float* srcC, float* dstL, float* dstC,
                const float* lng, const float* lnb, const float* modl, int sh_off, int sc_off, u16* H, bool writeH, bool h16 = false) {
  const int lane = TIDX & 63;
  const int gw = (blockIdx.x * 256 + TIDX) >> 6, nw = (gridDim.x * 256) >> 6;
  for (int r = gw; r < nrows; r += nw) {
    const float* src = r < TL ? srcL + (size_t)r * D : srcC + (size_t)(r - TL) * D;
    f32x4 v[4];
#pragma unroll
    for (int i = 0; i < 4; ++i) v[i] = *(const f32x4*)(src + i * 256 + lane * 4);
    float s = 0.f;
#pragma unroll
    for (int i = 0; i < 4; ++i) s += v[i][0] + v[i][1] + v[i][2] + v[i][3];
    float mu = wave_sum(s) * (1.f / D);
    float q = 0.f;
#pragma unroll
    for (int i = 0; i < 4; ++i)
#pragma unroll
      for (int j = 0; j < 4; ++j) { const float d = v[i][j] - mu; q += d * d; }
    float rstd = rsqrtf(wave_sum(q) * (1.f / D) + EPS);
    if (MODE == 1) {
      float* dst = r < TL ? dstL + (size_t)r * D : dstC + (size_t)(r - TL) * D;
      s = 0.f;
#pragma unroll
      for (int i = 0; i < 4; ++i) {
        const f32x4 g = *(const f32x4*)(lng + i * 256 + lane * 4), b = *(const f32x4*)(lnb + i * 256 + lane * 4);
#pragma unroll
        for (int j = 0; j < 4; ++j) { v[i][j] = (v[i][j] - mu) * rstd * g[j] + b[j]; s += v[i][j]; }
        *(f32x4*)(dst + i * 256 + lane * 4) = v[i];
      }
      if (!writeH) continue;
      mu = wave_sum(s) * (1.f / D);
      q = 0.f;
#pragma unroll
      for (int i = 0; i < 4; ++i)
#pragma unroll
        for (int j = 0; j < 4; ++j) { const float d = v[i][j] - mu; q += d * d; }
      rstd = rsqrtf(wave_sum(q) * (1.f / D) + EPS);
    }
    const float* mrow = modl + row_mod(r) * 6144;
#pragma unroll
    for (int i = 0; i < 4; ++i) {
      const f32x4 sh = *(const f32x4*)(mrow + sh_off + i * 256 + lane * 4), sc = *(const f32x4*)(mrow + sc_off + i * 256 + lane * 4);
      f32x4 h;
#pragma unroll
      for (int j = 0; j < 4; ++j) h[j] = (v[i][j] - mu) * rstd * (1.f + sc[j]) + sh[j];
      if (h16) st_h4(H + (size_t)r * D + i * 256 + lane * 4, h); else st_bf4(H + (size_t)r * D + i * 256 + lane * 4, h);
    }
  }
}

DI void phase_inproj(const Params& p, int l, u16* smem) {
  const u16* H = (const u16*)(p.ws + OFF_H);
  const u16* W = (const u16*)(p.ws + OFF_W0);
  u16* Pmla = (u16*)(p.ws + OFF_PMLA);
  u16* Z = (u16*)(p.ws + OFF_Z);
  u16* XR = (u16*)(p.ws + OFF_XR);
  float* DT = (float*)(p.ws + OFF_DT);
  u16* Pgqa = (u16*)(p.ws + OFF_PGQA);
  u16* VtG = (u16*)(p.ws + OFF_VTG);
  const float* cosG = (const float*)(p.ws + OFF_COSG);
  const float* sinG = (const float*)(p.ws + OFF_SING);
  const int tid = TIDX, lane = tid & 63, wid = tid >> 6, wm = wid >> 1, wn = wid & 1, lr = lane & 15, lq = lane >> 4;
  constexpr int MT = T / 128, NT = WINP / 128;
  XCD_TILE_LOOP(MT, NT) {
    int mt, nt;
    tile_xcd(j_, blockIdx.x & 7, MT >> 3, NT, mt, nt);
    if (l == 1 && mt >= TL / 128 && ((nt >= 6 && nt < 14) || (nt >= 27 && nt < 31))) continue;
    f32x4 acc[4][4];
    zero_acc<4>(acc);
    gemm_core<4>(H + (size_t)mt * 128 * 1024, 1024, W + (size_t)nt * 128 * 1024, 1024, 1024, acc, smem);
    const int rbase = mt * 128 + wm * 64 + lr;
    const int cw = wn * 64 + lq * 4;
    if (nt < 6) {
#pragma unroll
      for (int mi = 0; mi < 4; ++mi)
#pragma unroll
        for (int ni = 0; ni < 4; ++ni) {
          const int col = nt * 128 + cw + ni * 16;
          if (col < 672) st_bf4(Pmla + (size_t)(rbase + mi * 16) * 672 + col, acc[mi][ni]);
        }
    } else if (nt < 14) {
#pragma unroll
      for (int mi = 0; mi < 4; ++mi)
#pragma unroll
        for (int ni = 0; ni < 4; ++ni) st_bf4(Z + (size_t)(rbase + mi * 16) * 1024 + (nt - 6) * 128 + cw + ni * 16, acc[mi][ni]);
    } else if (nt < 26) {
#pragma unroll
      for (int mi = 0; mi < 4; ++mi)
#pragma unroll
        for (int ni = 0; ni < 4; ++ni) st_bf4(XR + (size_t)(rbase + mi * 16) * 1536 + (nt - 14) * 128 + cw + ni * 16, acc[mi][ni]);
    } else if (nt == 26) {
      if (wn == 0) {
#pragma unroll
        for (int mi = 0; mi < 4; ++mi)
#pragma unroll
          for (int ni = 0; ni < 2; ++ni) *(f32x4*)(DT + (size_t)(rbase + mi * 16) * 32 + lq * 4 + ni * 16) = acc[mi][ni];
      }
    } else if (nt < 32) {
      const float* g = (nt < 31) ? p.g_q_gqa + l * 64 : p.g_k_gqa + l * 64;
      const int dcol = (nt < 31) ? (nt - 27) * 128 + wn * 64 : 512 + wn * 64;
      f32x4 gv[4];
#pragma unroll
      for (int ni = 0; ni < 4; ++ni) gv[ni] = *(const f32x4*)(g + ni * 16 + lq * 4);
#pragma unroll
      for (int mi = 0; mi < 4; ++mi) {
        const int row = rbase + mi * 16;
        float ss = 0.f;
#pragma unroll
        for (int ni = 0; ni < 4; ++ni)
#pragma unroll
          for (int j = 0; j < 4; ++j) ss += acc[mi][ni][j] * acc[mi][ni][j];
        ss = quad_sum(ss);
        const float rstd = rsqrtf(ss * (1.f / 64.f) + EPS);
        f32x4 y[4];
#pragma unroll
        for (int ni = 0; ni < 4; ++ni)
#pragma unroll
          for (int j = 0; j < 4; ++j) y[ni][j] = acc[mi][ni][j] * rstd * gv[ni][j];
        if (row < TL) {
          const int pos = row & 4095;
#pragma unroll
          for (int ni = 0; ni < 2; ++ni) {
            const f32x4 cs = *(const f32x4*)(cosG + pos * 32 + ni * 16 + lq * 4), sn = *(const f32x4*)(sinG + pos * 32 + ni * 16 + lq * 4);
#pragma unroll
            for (int j = 0; j < 4; ++j) {
              const float x1 = y[ni][j], x2 = y[ni + 2][j];
              y[ni][j] = x1 * cs[j] - x2 * sn[j];
              y[ni + 2][j] = x1 * sn[j] + x2 * cs[j];
            }
          }
        }
#pragma unroll
        for (int ni = 0; ni < 4; ++ni) st_bf4(Pgqa + (size_t)row * 640 + dcol + ni * 16 + lq * 4, y[ni]);
      }
    } else {
#pragma unroll
      for (int mi = 0; mi < 4; ++mi) {
        const int row = rbase + mi * 16;
        const int b = row_batch(row), key = row_key(row);
        u16* vt = VtG + ((size_t)(b * 2 + wn) * 64) * NKEY + key;
#pragma unroll
        for (int ni = 0; ni < 4; ++ni)
#pragma unroll
          for (int j = 0; j < 4; ++j) vt[(size_t)(ni * 16 + lq * 4 + j) * NKEY] = f2bf(acc[mi][ni][j]);
      }
    }
  }
}

DI unsigned conv_word(unsigned w0, unsigned w1, unsigned w2, const float* cw, const float* cb, int ch) {
  const float lo = cw[ch] * bflo(w0) + cw[1536 + ch] * bflo(w1) + cw[3072 + ch] * bflo(w2) + cb[ch];
  const float hi = cw[ch + 1] * bfhi(w0) + cw[1536 + ch + 1] * bfhi(w1) + cw[3072 + ch + 1] * bfhi(w2) + cb[ch + 1];
  return pk2(siluf(lo), siluf(hi));
}
DI float sq_word(unsigned w) { const float x = bflo(w), y = bfhi(w); return x * x + y * y; }
DI void phase_c1(const Params& p, int l) {
  const u16* XR = (const u16*)(p.ws + OFF_XR);
  u16* XBC = (u16*)(p.ws + OFF_XBC);
  float* DT = (float*)(p.ws + OFF_DT);
  const u16* Pmla = (const u16*)(p.ws + OFF_PMLA);
  float* stats = (float*)(p.ws + OFF_STATS);
  const float* cw = p.conv_w + (size_t)l * 3 * 1536;
  const float* cb = p.conv_b + (size_t)l * 1536;
  const int gtid = blockIdx.x * 256 + TIDX, gn = gridDim.x * 256;
  for (int i = gtid; i < (T / 32) * 192; i += gn) {
    const int seg = i / 192, ch0 = (i % 192) * 8;
    const int row0 = seg * 32;
    bool first, last;
    if (row0 < TL) { const int pl = row0 & 4095; first = pl == 0; last = pl == 4096 - 32; }
    else { const int pj = (row0 - TL) & 255; first = pj == 0; last = pj == 256 - 32; }
    float w0[8], w1[8], w2[8], bb[8];
#pragma unroll
    for (int k = 0; k < 8; ++k) { w0[k] = cw[ch0 + k]; w1[k] = cw[1536 + ch0 + k]; w2[k] = cw[3072 + ch0 + k]; bb[k] = cb[ch0 + k]; }
    const uint4 z4 = make_uint4(0u, 0u, 0u, 0u);
    uint4 up = z4;
    if (!first) up = *(const uint4*)(XR + (size_t)(row0 - 1) * 1536 + ch0);
    uint4 uc = *(const uint4*)(XR + (size_t)row0 * 1536 + ch0);
#pragma unroll 4
    for (int r = 0; r < 32; ++r) {
      const int row = row0 + r;
      uint4 un = z4;
      if (r < 31 || !last) un = *(const uint4*)(XR + (size_t)(row + 1) * 1536 + ch0);
      uint4 ov;
      {
        const float lo = w0[0] * bflo(up.x) + w1[0] * bflo(uc.x) + w2[0] * bflo(un.x) + bb[0];
        const float hi = w0[1] * bfhi(up.x) + w1[1] * bfhi(uc.x) + w2[1] * bfhi(un.x) + bb[1];
        ov.x = pk2(siluf(lo), siluf(hi));
      }
      {
        const float lo = w0[2] * bflo(up.y) + w1[2] * bflo(uc.y) + w2[2] * bflo(un.y) + bb[2];
        const float hi = w0[3] * bfhi(up.y) + w1[3] * bfhi(uc.y) + w2[3] * bfhi(un.y) + bb[3];
        ov.y = pk2(siluf(lo), siluf(hi));
      }
      {
        const float lo = w0[4] * bflo(up.z) + w1[4] * bflo(uc.z) + w2[4] * bflo(un.z) + bb[4];
        const float hi = w0[5] * bfhi(up.z) + w1[5] * bfhi(uc.z) + w2[5] * bfhi(un.z) + bb[5];
        ov.z = pk2(siluf(lo), siluf(hi));
      }
      {
        const float lo = w0[6] * bflo(up.w) + w1[6] * bflo(uc.w) + w2[6] * bflo(un.w) + bb[6];
        const float hi = w0[7] * bfhi(up.w) + w1[7] * bfhi(uc.w) + w2[7] * bfhi(un.w) + bb[7];
        ov.w = pk2(siluf(lo), siluf(hi));
      }
      *(uint4*)(XBC + (size_t)row * 1536 + ch0) = ov;
      up = uc;
      uc = un;
    }
  }
  for (int i = gtid; i < T * 32; i += gn) {
    const float v = DT[i] + p.dt_bias[l * 32 + (i & 31)];
    const float e = __expf(-fabsf(v));
    const float lp = e < 0.01f ? e * (1.f - e * (0.5f - e * (1.f / 3.f))) : __logf(1.f + e);
    DT[i] = fmaxf(v, 0.f) + lp;
  }
  const int lane = TIDX & 63;
  const int gw = gtid >> 6, nw = gn >> 6;
  for (int r = gw; r < T; r += nw) {
    float sq = 0.f, sk = 0.f;
    if (lane < 48) {
      const uint4 u = *(const uint4*)(Pmla + (size_t)r * 672 + lane * 8);
      sq = sq_word(u.x) + sq_word(u.y) + sq_word(u.z) + sq_word(u.w);
    }
    if (lane < 32) {
      const uint4 u = *(const uint4*)(Pmla + (size_t)r * 672 + 384 + lane * 8);
      sk = sq_word(u.x) + sq_word(u.y) + sq_word(u.z) + sq_word(u.w);
    }
    sq = wave_sum(sq);
    sk = wave_sum(sk);
    if (lane == 0) {
      stats[r * 2] = rsqrtf(sq * (1.f / 384.f) + EPS);
      stats[r * 2 + 1] = rsqrtf(sk * (1.f / 256.f) + EPS);
    }
  }
}

DI void phase_c2(const Params& p, int l, u16* smem) {
  const u16* Pmla = (const u16*)(p.ws + OFF_PMLA);
  const u16* W0 = (const u16*)(p.ws + OFF_W0);
  u16* Qm = (u16*)(p.ws + OFF_QM);
  u16* Km = (u16*)(p.ws + OFF_KM);
  u16* VtM = (u16*)(p.ws + OFF_VTM);
  const float* stats = (const float*)(p.ws + OFF_STATS);
  const float* cosM = (const float*)(p.ws + OFF_COSM);
  const float* sinM = (const float*)(p.ws + OFF_SINM);
  const int tid = TIDX, lane = tid & 63, wid = tid >> 6, wm = wid >> 1, wn = wid & 1, lr = lane & 15, lq = lane >> 4;
  constexpr int MT = T / 128;
  XCD_TILE_LOOP(MT, 14) {
    f32x4 acc[4][4];
    zero_acc<4>(acc);
    int mt, nt;
    tile_xcd(j_, blockIdx.x & 7, MT >> 3, 14, mt, nt);
    if (nt < 6) {
      gemm_core<4>(Pmla + (size_t)mt * 128 * 672, 672, W0 + W0_UQ + (size_t)nt * 128 * 384, 384, 384, acc, smem);
      const int rbase = mt * 128 + wm * 64 + lr;
      const int c0 = nt * 128 + wn * 64;
      const int g0 = c0 >> 4;
#pragma unroll
      for (int mi = 0; mi < 4; ++mi) {
        const int row = rbase + mi * 16;
        const float rs = stats[row * 2];
        f32x4 y[4];
#pragma unroll
        for (int ni = 0; ni < 4; ++ni) y[ni] = acc[mi][ni] * rs;
        if (row < TL) {
          const int pos = row & 4095;
          const f32x4 cs = *(const f32x4*)(cosM + pos * 16 + lq * 4), sn = *(const f32x4*)(sinM + pos * 16 + lq * 4);
#pragma unroll
          for (int ni = 0; ni < 3; ++ni) {
            if ((g0 + ni) % 6 == 4) {
#pragma unroll
              for (int j = 0; j < 4; ++j) {
                const float x1 = y[ni][j], x2 = y[ni + 1][j];
                y[ni][j] = x1 * cs[j] - x2 * sn[j];
                y[ni + 1][j] = x1 * sn[j] + x2 * cs[j];
              }
            }
          }
        }
#pragma unroll
        for (int ni = 0; ni < 4; ++ni) st_bf4(Qm + (size_t)row * 768 + c0 + ni * 16 + lq * 4, y[ni]);
      }
    } else {
      nt -= 6;
      gemm_core<4>(Pmla + (size_t)mt * 128 * 672 + 384, 672, W0 + W0_UKV + (size_t)nt * 128 * 256, 256, 256, acc, smem);
      const int rbase = mt * 128 + wm * 64 + lr;
#pragma unroll
      for (int mi = 0; mi < 4; ++mi) {
        const int row = rbase + mi * 16;
        const float rs = stats[row * 2 + 1];
        if (wn == 0) {
#pragma unroll
          for (int ni = 0; ni < 4; ++ni) st_bf4(Km + (size_t)row * 768 + nt * 96 + ni * 16 + lq * 4, acc[mi][ni] * rs);
        } else {
          const int b = row_batch(row), key = row_key(row);
          u16* vt = VtM + ((size_t)(b * 8 + nt) * 64) * NKEY + key;
#pragma unroll
          for (int ni = 0; ni < 4; ++ni)
#pragma unroll
            for (int j = 0; j < 4; ++j) vt[(size_t)(ni * 16 + lq * 4 + j) * NKEY] = f2bf(acc[mi][ni][j] * rs);
        }
      }
    }
  }
  const int gtid = blockIdx.x * 256 + tid, gn = gridDim.x * 256;
  for (int i = gtid; i < T * 16; i += gn) {
    const int row = i >> 4, j = i & 15;
    float x1 = bf2f(Pmla[(size_t)row * 672 + 640 + j]), x2 = bf2f(Pmla[(size_t)row * 672 + 656 + j]);
    if (row < TL) {
      const int pos = row & 4095;
      const float cs = cosM[pos * 16 + j], sn = sinM[pos * 16 + j];
      const float a = x1 * cs - x2 * sn, b = x1 * sn + x2 * cs;
      x1 = a; x2 = b;
    }
    const u16 h1 = f2bf(x1), h2 = f2bf(x2);
#pragma unroll
    for (int h = 0; h < 8; ++h) {
      Km[(size_t)row * 768 + h * 96 + 64 + j] = h1;
      Km[(size_t)row * 768 + h * 96 + 80 + j] = h2;
    }
  }
}

template <int DQK, bool NOMAX>
DI void attn_item(const u16* __restrict__ Q, int ldq, int qoff, const u16* __restrict__ Kp, int ldk, int koff,
                  const u16* __restrict__ Vt, u16* __restrict__ Y, int yoff, int b, int qrow0, int nkt, float sl2, float c0, u16* smem) {
  constexpr int KS = DQK / 32;
  constexpr int KB = KS * 4096, STG = KB + 8192;
  char* sbase = (char*)smem;
  const int tid = TIDX, lane = tid & 63, wid = tid >> 6, lr = lane & 15, lq = lane >> 4;
  bf16x8 qf[2][KS];
#pragma unroll
  for (int qi = 0; qi < 2; ++qi)
#pragma unroll
    for (int ks = 0; ks < KS; ++ks)
      qf[qi][ks] = *(const bf16x8*)(Q + (size_t)(qrow0 + wid * 32 + qi * 16 + lr) * ldq + qoff + ks * 32 + lq * 8);
  f32x4 o[4][2];
#pragma unroll
  for (int i = 0; i < 4; ++i)
#pragma unroll
    for (int j = 0; j < 2; ++j) o[i][j] = (f32x4){0.f, 0.f, 0.f, 0.f};
  float mrun[2] = {-1e30f, -1e30f}, lrun[2] = {0.f, 0.f};
  const int drow = tid >> 2, dch = (tid & 3) ^ ((drow >> 2) & 3);
  const int wq = __builtin_amdgcn_readfirstlane(wid) * 1024;
  const u16* vsrc = Vt + (size_t)drow * NKEY + dch * 8;
#define ATT_ISSUE(KT, BUF)                                                                                           \
  {                                                                                                                  \
    const int kt_ = (KT) < nkt ? (KT) : nkt - 1;                                                                     \
    const int r0_ = kt_ < 4 ? TL + b * CTXL + kt_ * 64 : b * SEQ + (kt_ - 4) * 64;                                   \
    const u16* ksrc_ = Kp + (size_t)(r0_ + drow) * ldk + koff + dch * 8;                                             \
    _Pragma("unroll") for (int ks = 0; ks < KS; ++ks)                                                                \
        __builtin_amdgcn_global_load_lds((const GAS unsigned*)(ksrc_ + ks * 32),                                     \
                                         (LAS3 unsigned*)(sbase + (BUF) * STG + ks * 4096 + wq), 16, 0, 0);          \
    _Pragma("unroll") for (int u = 0; u < 2; ++u)                                                                    \
        __builtin_amdgcn_global_load_lds((const GAS unsigned*)(vsrc + kt_ * 64 + u * 32),                            \
                                         (LAS3 unsigned*)(sbase + (BUF) * STG + KB + u * 4096 + wq), 16, 0, 0);      \
  }
  const unsigned lbase = (unsigned)(size_t)((LAS3 char*)sbase);
  const unsigned kaddr = lbase + lr * 64 + ((lq ^ ((lr >> 2) & 3)) << 4);
  const unsigned vaddr0 = lbase + KB + lr * 64 + ((((lq >> 1)) ^ ((lr >> 2) & 3)) << 4) + (lq & 1) * 8;
  const unsigned vaddr1 = lbase + KB + lr * 64 + ((((lq >> 1) + 2) ^ ((lr >> 2) & 3)) << 4) + (lq & 1) * 8;
#define LDSR128(dst, addr, off) asm volatile("ds_read_b128 %0, %1 offset:%2" : "=v"(dst) : "v"(addr), "n"(off))
#define LDSR64(dst, addr, off) asm volatile("ds_read_b64 %0, %1 offset:%2" : "=v"(dst) : "v"(addr), "n"(off))
#define ATT_COMPUTE(BUF)                                                                                             \
  {                                                                                                                  \
    f32x4 s[4][2];                                                                                                   \
    _Pragma("unroll") for (int kk = 0; kk < 4; ++kk) {                                                               \
      bf16x8 kf[KS];                                                                                                 \
      LDSR128(kf[0], kaddr, (BUF) * STG + 0 * 4096 + kk * 1024);                                                     \
      LDSR128(kf[1], kaddr, (BUF) * STG + 1 * 4096 + kk * 1024);                                                     \
      if (KS == 3) LDSR128(kf[KS - 1], kaddr, (BUF) * STG + 2 * 4096 + kk * 1024);                                   \
      if (KS == 3) asm volatile("s_waitcnt lgkmcnt(0)" : "+v"(kf[0]), "+v"(kf[1]), "+v"(kf[KS - 1]));                \
      else asm volatile("s_waitcnt lgkmcnt(0)" : "+v"(kf[0]), "+v"(kf[1]));                                          \
      s[kk][0] = (f32x4){0.f, 0.f, 0.f, 0.f};                                                                        \
      s[kk][1] = (f32x4){0.f, 0.f, 0.f, 0.f};                                                                        \
      _Pragma("unroll") for (int ks = 0; ks < KS; ++ks) {                                                            \
        s[kk][0] = mma16<true>(kf[ks], qf[0][ks], s[kk][0]);                    \
        s[kk][1] = mma16<true>(kf[ks], qf[1][ks], s[kk][1]);                    \
      }                                                                                                              \
    }                                                                                                                \
    uint2 vlo[2][4], vhi[2][4];                                                                                      \
    _Pragma("unroll") for (int u = 0; u < 2; ++u) {                                                                  \
      LDSR64(vlo[u][0], vaddr0, (BUF) * STG + u * 4096 + 0 * 1024); LDSR64(vhi[u][0], vaddr1, (BUF) * STG + u * 4096 + 0 * 1024); \
      LDSR64(vlo[u][1], vaddr0, (BUF) * STG + u * 4096 + 1 * 1024); LDSR64(vhi[u][1], vaddr1, (BUF) * STG + u * 4096 + 1 * 1024); \
      LDSR64(vlo[u][2], vaddr0, (BUF) * STG + u * 4096 + 2 * 1024); LDSR64(vhi[u][2], vaddr1, (BUF) * STG + u * 4096 + 2 * 1024); \
      LDSR64(vlo[u][3], vaddr0, (BUF) * STG + u * 4096 + 3 * 1024); LDSR64(vhi[u][3], vaddr1, (BUF) * STG + u * 4096 + 3 * 1024); \
    }                                                                                                                \
    bf16x8 pf[2][2];                                                                                                 \
    _Pragma("unroll") for (int qi = 0; qi < 2; ++qi) {                                                               \
      float ps = 0.f;                                                                                                \
      float pv[4][4];                                                                                                \
      if (NOMAX) {                                                                                                   \
        _Pragma("unroll") for (int kk = 0; kk < 4; ++kk)                                                             \
            _Pragma("unroll") for (int j = 0; j < 4; ++j) {                                                          \
          const float e = __builtin_amdgcn_exp2f(s[kk][qi][j] * sl2 - c0);                                           \
          pv[kk][j] = e;                                                                                             \
          ps += e;                                                                                                   \
        }                                                                                                            \
      } else {                                                                                                       \
        float mx = -1e30f;                                                                                           \
        _Pragma("unroll") for (int kk = 0; kk < 4; ++kk)                                                             \
            _Pragma("unroll") for (int j = 0; j < 4; ++j) mx = fmaxf(mx, s[kk][qi][j]);                              \
        mx = quad_max(mx);                                                                                           \
        const float mnew = fmaxf(mrun[qi], mx * sl2);                                                                \
        const float alpha = __builtin_amdgcn_exp2f(mrun[qi] - mnew);                                                 \
        mrun[qi] = mnew;                                                                                             \
        _Pragma("unroll") for (int kk = 0; kk < 4; ++kk)                                                             \
            _Pragma("unroll") for (int j = 0; j < 4; ++j) {                                                          \
          const float e = __builtin_amdgcn_exp2f(s[kk][qi][j] * sl2 - mnew);                                         \
          pv[kk][j] = e;                                                                                             \
          ps += e;                                                                                                   \
        }                                                                                                            \
        if (__builtin_amdgcn_ballot_w64(alpha != 1.0f)) {                                                            \
          lrun[qi] *= alpha;                                                                                         \
          _Pragma("unroll") for (int dt = 0; dt < 4; ++dt) o[dt][qi] *= alpha;                                       \
        }                                                                                                            \
      }                                                                                                              \
      lrun[qi] += ps;                                                                                                \
      _Pragma("unroll") for (int u = 0; u < 2; ++u) {                                                                \
        union { bf16x8 v; unsigned w[4]; } pk;                                                                       \
        pk.w[0] = pk2(pv[2 * u][0], pv[2 * u][1]);                                                                   \
        pk.w[1] = pk2(pv[2 * u][2], pv[2 * u][3]);                                                                   \
        pk.w[2] = pk2(pv[2 * u + 1][0], pv[2 * u + 1][1]);                                                           \
        pk.w[3] = pk2(pv[2 * u + 1][2], pv[2 * u + 1][3]);                                                           \
        pf[qi][u] = pk.v;                                                                                            \
      }                                                                                                              \
    }                                                                                                                \
    asm volatile("s_waitcnt lgkmcnt(0)"                                                                              \
                 : "+v"(vlo[0][0]), "+v"(vlo[0][1]), "+v"(vlo[0][2]), "+v"(vlo[0][3]), "+v"(vhi[0][0]), "+v"(vhi[0][1]), \
                   "+v"(vhi[0][2]), "+v"(vhi[0][3]), "+v"(vlo[1][0]), "+v"(vlo[1][1]), "+v"(vlo[1][2]), "+v"(vlo[1][3]), \
                   "+v"(vhi[1][0]), "+v"(vhi[1][1]), "+v"(vhi[1][2]), "+v"(vhi[1][3]));                              \
    _Pragma("unroll") for (int u = 0; u < 2; ++u)                                                                    \
        _Pragma("unroll") for (int dt = 0; dt < 4; ++dt) {                                                           \
      union { bf16x8 v; uint2 h[2]; } vf;                                                                            \
      vf.h[0] = vlo[u][dt];                                                                                          \
      vf.h[1] = vhi[u][dt];                                                                                          \
      o[dt][0] = mma16<true>(vf.v, pf[0][u], o[dt][0]);                         \
      o[dt][1] = mma16<true>(vf.v, pf[1][u], o[dt][1]);                         \
    }                                                                                                                \
  }
  if (DQK == 64 && NOMAX) {
    f32x4 sc[4][2], sn[4][2];
#define ATT_KREAD(BUF)                                                                                               \
    _Pragma("unroll") for (int kk = 0; kk < 4; ++kk) {                                                               \
      LDSR128(kf[kk][0], kaddr, (BUF) * STG + 0 * 4096 + kk * 1024);                                                 \
      LDSR128(kf[kk][1], kaddr, (BUF) * STG + 1 * 4096 + kk * 1024);                                                 \
    }
#define ATT_VREAD(BUF)                                                                                               \
    _Pragma("unroll") for (int u = 0; u < 2; ++u) {                                                                  \
      LDSR64(vlo[u][0], vaddr0, (BUF) * STG + u * 4096 + 0 * 1024); LDSR64(vhi[u][0], vaddr1, (BUF) * STG + u * 4096 + 0 * 1024); \
      LDSR64(vlo[u][1], vaddr0, (BUF) * STG + u * 4096 + 1 * 1024); LDSR64(vhi[u][1], vaddr1, (BUF) * STG + u * 4096 + 1 * 1024); \
      LDSR64(vlo[u][2], vaddr0, (BUF) * STG + u * 4096 + 2 * 1024); LDSR64(vhi[u][2], vaddr1, (BUF) * STG + u * 4096 + 2 * 1024); \
      LDSR64(vlo[u][3], vaddr0, (BUF) * STG + u * 4096 + 3 * 1024); LDSR64(vhi[u][3], vaddr1, (BUF) * STG + u * 4096 + 3 * 1024); \
    }
#define ATT_KWAIT()                                                                                                  \
    asm volatile("s_waitcnt lgkmcnt(0)" : "+v"(kf[0][0]), "+v"(kf[0][1]), "+v"(kf[1][0]), "+v"(kf[1][1]), "+v"(kf[2][0]), "+v"(kf[2][1]), "+v"(kf[3][0]), "+v"(kf[3][1]));
#define ATT_VWAIT()                                                                                                  \
    asm volatile("s_waitcnt lgkmcnt(0)"                                                                              \
                 : "+v"(vlo[0][0]), "+v"(vlo[0][1]), "+v"(vlo[0][2]), "+v"(vlo[0][3]), "+v"(vhi[0][0]), "+v"(vhi[0][1]), \
                   "+v"(vhi[0][2]), "+v"(vhi[0][3]), "+v"(vlo[1][0]), "+v"(vlo[1][1]), "+v"(vlo[1][2]), "+v"(vlo[1][3]), \
                   "+v"(vhi[1][0]), "+v"(vhi[1][1]), "+v"(vhi[1][2]), "+v"(vhi[1][3]));
#define ATT_SMMA(s)                                                                                                  \
    _Pragma("unroll") for (int kk = 0; kk < 4; ++kk) {                                                               \
      s[kk][0] = (f32x4){0.f, 0.f, 0.f, 0.f};                                                                        \
      s[kk][1] = (f32x4){0.f, 0.f, 0.f, 0.f};                                                                        \
      _Pragma("unroll") for (int ks = 0; ks < 2; ++ks) {                                                             \
        s[kk][0] = mma16<true>(kf[kk][ks], qf[0][ks], s[kk][0]);                                                     \
        s[kk][1] = mma16<true>(kf[kk][ks], qf[1][ks], s[kk][1]);                                                     \
      }                                                                                                              \
    }
#define ATT_STEP2(KT, ST, SN)                                                                                        \
    if ((KT) < nkt) {                                                                                                \
      asm volatile("s_waitcnt vmcnt(0)" ::: "memory");                                                               \
      __builtin_amdgcn_s_barrier();                                                                                  \
      ATT_ISSUE((KT) + 2, ((ST) + 2) % 3)                                                                            \
      bf16x8 kf[4][2];                                                                                               \
      uint2 vlo[2][4], vhi[2][4];                                                                                    \
      if ((KT) + 1 < nkt) { ATT_KREAD(SN) } else { ATT_KREAD(ST) }                                                   \
      ATT_KWAIT()                                                                                                    \
      ATT_VREAD(ST)                                                                                                  \
      ATT_SMMA(sn)                                                                                                   \
      bf16x8 pf[2][2];                                                                                               \
      _Pragma("unroll") for (int qi = 0; qi < 2; ++qi) {                                                             \
        float ps = 0.f;                                                                                              \
        float pv[4][4];                                                                                              \
        _Pragma("unroll") for (int kk = 0; kk < 4; ++kk)                                                             \
            _Pragma("unroll") for (int j = 0; j < 4; ++j) {                                                          \
          const float e = __builtin_amdgcn_exp2f(sc[kk][qi][j] * sl2 - c0);                                          \
          pv[kk][j] = e;                                                                                             \
          ps += e;                                                                                                   \
        }                                                                                                            \
        lrun[qi] += ps;                                                                                              \
        _Pragma("unroll") for (int u = 0; u < 2; ++u) {                                                              \
          union { bf16x8 v; unsigned w[4]; } pk;                                                                     \
          pk.w[0] = pk2(pv[2 * u][0], pv[2 * u][1]);                                                                 \
          pk.w[1] = pk2(pv[2 * u][2], pv[2 * u][3]);                                                                 \
          pk.w[2] = pk2(pv[2 * u + 1][0], pv[2 * u + 1][1]);                                                         \
          pk.w[3] = pk2(pv[2 * u + 1][2], pv[2 * u + 1][3]);                                                         \
          pf[qi][u] = pk.v;                                                                                          \
        }                                                                                                            \
      }                                                                                                              \
      ATT_VWAIT()                                                                                                    \
      _Pragma("unroll") for (int u = 0; u < 2; ++u)                                                                  \
          _Pragma("unroll") for (int dt = 0; dt < 4; ++dt) {                                                         \
        union { bf16x8 v; uint2 h[2]; } vf;                                                                          \
        vf.h[0] = vlo[u][dt];                                                                                        \
        vf.h[1] = vhi[u][dt];                                                                                        \
        o[dt][0] = mma16<true>(vf.v, pf[0][u], o[dt][0]);                                                            \
        o[dt][1] = mma16<true>(vf.v, pf[1][u], o[dt][1]);                                                            \
      }                                                                                                              \
      _Pragma("unroll") for (int kk = 0; kk < 4; ++kk) { sc[kk][0] = sn[kk][0]; sc[kk][1] = sn[kk][1]; }             \
    }
    ATT_ISSUE(0, 0)
    ATT_ISSUE(1, 1)
    asm volatile("s_waitcnt vmcnt(%0)" ::"n"(KS + 2) : "memory");
    __builtin_amdgcn_s_barrier();
    {
      bf16x8 kf[4][2];
      ATT_KREAD(0)
      asm volatile("s_waitcnt lgkmcnt(0)" : "+v"(kf[0][0]), "+v"(kf[0][1]), "+v"(kf[1][0]), "+v"(kf[1][1]), "+v"(kf[2][0]), "+v"(kf[2][1]), "+v"(kf[3][0]), "+v"(kf[3][1]));
      ATT_SMMA(sc)
    }
    for (int kt = 0; kt < nkt; kt += 3) {
      ATT_STEP2(kt, 0, 1)
      ATT_STEP2(kt + 1, 1, 2)
      ATT_STEP2(kt + 2, 2, 0)
    }
    asm volatile("s_waitcnt vmcnt(0)" ::: "memory");
    __builtin_amdgcn_s_barrier();
#undef ATT_STEP2
#undef ATT_SMMA
#undef ATT_VWAIT
#undef ATT_KWAIT
#undef ATT_VREAD
#undef ATT_KREAD
  } else {
#define ATT_STEP(KT, ST)                                                                                             \
  if ((KT) < nkt) {                                                                                                  \
    asm volatile("s_waitcnt vmcnt(%0)" ::"n"(KS + 2) : "memory");                                                    \
    __builtin_amdgcn_s_barrier();                                                                                    \
    ATT_ISSUE((KT) + 2, ((ST) + 2) % 3)                                                                              \
    ATT_COMPUTE(ST)                                                                                                  \
  }
  ATT_ISSUE(0, 0)
  ATT_ISSUE(1, 1)
  for (int kt = 0; kt < nkt; kt += 3) {
    ATT_STEP(kt, 0)
    ATT_STEP(kt + 1, 1)
    ATT_STEP(kt + 2, 2)
  }
  asm volatile("s_waitcnt vmcnt(0)" ::: "memory");
  __builtin_amdgcn_s_barrier();
  }
#undef ATT_STEP
#undef ATT_COMPUTE
#undef ATT_ISSUE
#undef LDSR128
#undef LDSR64
#pragma unroll
  for (int qi = 0; qi < 2; ++qi) {
    const float lt = quad_sum(lrun[qi]);
    const float inv = 1.f / lt;
    const int row = qrow0 + wid * 32 + qi * 16 + lr;
#pragma unroll
    for (int dt = 0; dt < 4; ++dt) st_bf4(Y + (size_t)row * 512 + yoff + dt * 16 + lq * 4, o[dt][qi] * inv);
  }
}

DI void phase_attn(const Params& p, int l, bool with_ctx, u16* smem) {
  const u16* Qm = (const u16*)(p.ws + OFF_QM);
  const u16* Km = (const u16*)(p.ws + OFF_KM);
  const u16* VtM = (const u16*)(p.ws + OFF_VTM);
  u16* Ymla = (u16*)(p.ws + OFF_YMLA);
  const u16* Pgqa = (const u16*)(p.ws + OFF_PGQA);
  const u16* VtG = (const u16*)(p.ws + OFF_VTG);
  u16* Ygqa = (u16*)(p.ws + OFF_YGQA);
  const float sl2_mla = 0.10206207261596575f * 1.4426950408889634f;
  const float sl2_gqa = 0.125f * 1.4426950408889634f;
  float c0_gqa;
  {
    const int ln = TIDX & 63;
    float gq = fabsf(p.g_q_gqa[l * 64 + ln]), gk = fabsf(p.g_k_gqa[l * 64 + ln]);
#pragma unroll
    for (int o = 32; o > 0; o >>= 1) { gq = fmaxf(gq, __shfl_xor(gq, o)); gk = fmaxf(gk, __shfl_xor(gk, o)); }
    const float bound = 8.f * gq * gk * 1.01f;
    c0_gqa = fmaxf(0.f, bound - 10.f) * 1.4426950408889634f;
  }
  const int xcd = blockIdx.x & 7, slots = gridDim.x >> 3;
  const int per_xcd = 256 + (with_ctx ? 16 : 0);
  for (int q = blockIdx.x >> 3; q < per_xcd; q += slots) {
    int kind, b, h, qrow0, nkt;
    if (q < 128) {
      const int P = xcd * 4 + (q >> 5);
      kind = 0; b = P >> 3; h = P & 7;
      qrow0 = b * SEQ + (q & 31) * 128;
      nkt = NKEY / 64;
    } else if (q < 256) {
      const int q2 = q - 128;
      kind = 1; b = xcd >> 1; h = (xcd & 1) * 4 + (q2 >> 5);
      qrow0 = b * SEQ + (q2 & 31) * 128;
      nkt = NKEY / 64;
    } else {
      const int q3 = q - 256;
      kind = q3 & 1;
      const int j = xcd * 8 + (q3 >> 1);
      const int qt = j & 1; h = (j >> 1) & 7; b = j >> 4;
      qrow0 = TL + b * CTXL + qt * 128;
      nkt = CTXL / 64;
    }
    if (kind == 0)
      attn_item<96, false>(Qm, 768, h * 96, Km, 768, h * 96, VtM + (size_t)(b * 8 + h) * 64 * NKEY, Ymla, h * 64, b, qrow0, nkt, sl2_mla, 0.f, smem);
    else
      attn_item<64, true>(Pgqa, 640, h * 64, Pgqa, 640, 512 + (h >> 2) * 64, VtG + (size_t)(b * 2 + (h >> 2)) * 64 * NKEY, Ygqa, h * 64, b, qrow0, nkt, sl2_gqa, c0_gqa, smem);
  }
}

DI int chunk_row0(int b, int m) { return m < 2 ? TL + b * CTXL + m * 128 : b * SEQ + (m - 2) * 128; }
DI int chunk_scan_idx(int dir, int m) { return dir == 0 ? m : (m < 2 ? 1 - m : 35 - m); }
constexpr int LDX = 136;

DI void ssd_cums(const Params& p, int l, int h, int r0, float* sw, float* scum, float* sdt, float& tot_out) {
  const int lane = TIDX & 63, dir = TIDX >> 6;
  const float* DT = (const float*)(p.ws + OFF_DT);
  const float a = -__expf(p.a_log[l * 32 + dir * 16 + h]);
  const int k0 = lane * 2;
  const float d0 = DT[(size_t)(r0 + k0) * 32 + dir * 16 + h], d1 = DT[(size_t)(r0 + k0 + 1) * 32 + dir * 16 + h];
  const float v0 = a * d0, v1 = a * d1;
  float inc = v0 + v1;
#pragma unroll
  for (int off = 1; off < 64; off <<= 1) {
    const float t = __shfl_up(inc, off);
    if (lane >= off) inc += t;
  }
  const float c1 = inc, c0 = inc - v1;
  const float tot = __shfl(inc, 63);
  tot_out = tot;
  if (dir == 0) {
    sw[k0] = __expf(tot - c0) * d0;
    sw[k0 + 1] = __expf(tot - c1) * d1;
    scum[k0] = c0;
    scum[k0 + 1] = c1;
  } else {
    sw[128 + k0] = __expf(c0 - v0) * d0;
    sw[128 + k0 + 1] = __expf(c1 - v1) * d1;
    scum[128 + k0] = tot - c0 + v0;
    scum[128 + k0 + 1] = tot - c1 + v1;
  }
  sdt[dir * 128 + k0] = d0;
  sdt[dir * 128 + k0 + 1] = d1;
}

struct XRegs { uint4 u[4]; };
DI XRegs ssd_load_x(const u16* XBC, int r0, int h) {
  const int lane = TIDX & 63, wid = TIDX >> 6;
  const int k0 = lane * 2;
  XRegs x;
#pragma unroll
  for (int it = 0; it < 2; ++it) {
    const int cn = wid + 4 * it;
    x.u[2 * it] = *(const uint4*)(XBC + (size_t)(r0 + k0) * 1536 + h * 64 + cn * 8);
    x.u[2 * it + 1] = *(const uint4*)(XBC + (size_t)(r0 + k0 + 1) * 1536 + h * 64 + cn * 8);
  }
  return x;
}
DI void ssd_write_xt(const XRegs& x, const float* scale, u16* sXt) {
  const int lane = TIDX & 63, wid = TIDX >> 6;
  const int k0 = lane * 2;
#pragma unroll
  for (int it = 0; it < 2; ++it) {
    const int cn = wid + 4 * it;
    const uint4 u0 = x.u[2 * it], u1 = x.u[2 * it + 1];
#pragma unroll
    for (int dir = 0; dir < 2; ++dir) {
      const float s0 = scale[dir * 128 + k0], s1 = scale[dir * 128 + k0 + 1];
      u16* dst = sXt + dir * 64 * LDX + (cn * 8) * LDX + k0;
      *(unsigned*)(dst + 0 * LDX) = pk2(bflo(u0.x) * s0, bflo(u1.x) * s1);
      *(unsigned*)(dst + 1 * LDX) = pk2(bfhi(u0.x) * s0, bfhi(u1.x) * s1);
      *(unsigned*)(dst + 2 * LDX) = pk2(bflo(u0.y) * s0, bflo(u1.y) * s1);
      *(unsigned*)(dst + 3 * LDX) = pk2(bfhi(u0.y) * s0, bfhi(u1.y) * s1);
      *(unsigned*)(dst + 4 * LDX) = pk2(bflo(u0.z) * s0, bflo(u1.z) * s1);
      *(unsigned*)(dst + 5 * LDX) = pk2(bfhi(u0.z) * s0, bfhi(u1.z) * s1);
      *(unsigned*)(dst + 6 * LDX) = pk2(bflo(u0.w) * s0, bflo(u1.w) * s1);
      *(unsigned*)(dst + 7 * LDX) = pk2(bfhi(u0.w) * s0, bfhi(u1.w) * s1);
    }
  }
}

DI void phase_ssd_states(const Params& p, int l, u16* smem) {
  const u16* XBC = (const u16*)(p.ws + OFF_XBC);
  u16* S = (u16*)(p.ws + OFF_S);
  float* chdec = (float*)(p.ws + OFF_CHDEC);
  u16* sBt = smem;
  u16* sXt = smem + 128 * LDX;
  float* sw = (float*)(smem + 256 * LDX);
  float* scum = sw + 256;
  float* sdt = scum + 256;
  const int tid = TIDX, lane = tid & 63, wid = tid >> 6, lr = lane & 15, lq = lane >> 4;
  for (int it = blockIdx.x; it < NBATCH * NCH * 16; it += gridDim.x) {
    const int h = it & 15, m = (it >> 4) % NCH, b = it / (16 * NCH);
    const int r0 = chunk_row0(b, m), g = h >> 3;
    if (wid < 2) {
      float tot;
      ssd_cums(p, l, h, r0, sw, scum, sdt, tot);
      if (lane == 0) chdec[((wid * 4 + b) * NCH + chunk_scan_idx(wid, m)) * 16 + h] = __expf(tot);
    }
    {
      const int k0 = lane * 2;
#pragma unroll
      for (int i4 = 0; i4 < 4; ++i4) {
        const int cn = wid + 4 * i4;
        const uint4 u0 = *(const uint4*)(XBC + (size_t)(r0 + k0) * 1536 + 1024 + g * 128 + cn * 8);
        const uint4 u1 = *(const uint4*)(XBC + (size_t)(r0 + k0 + 1) * 1536 + 1024 + g * 128 + cn * 8);
        const unsigned a0[4] = {u0.x, u0.y, u0.z, u0.w}, a1[4] = {u1.x, u1.y, u1.z, u1.w};
        u16* dst = sBt + (cn * 8) * LDX + k0;
#pragma unroll
        for (int e = 0; e < 4; ++e) {
          *(unsigned*)(dst + (2 * e) * LDX) = (a0[e] & 0xffffu) | (a1[e] << 16);
          *(unsigned*)(dst + (2 * e + 1) * LDX) = (a0[e] >> 16) | (a1[e] & 0xffff0000u);
        }
      }
    }
    const XRegs xr = ssd_load_x(XBC, r0, h);
    __syncthreads();
    ssd_write_xt(xr, sw, sXt);
    __syncthreads();
    {
      const int dir = wid >> 1, nh = wid & 1;
      f32x4 acc[4][4];
      zero_acc<4>(acc);
      const u16* b_s = sBt + (nh * 64 + lr) * LDX + lq * 8;
      const u16* x_s = sXt + dir * 64 * LDX + lr * LDX + lq * 8;
#pragma unroll
      for (int ks = 0; ks < 4; ++ks) {
        bf16x8 bfv[4], xf[4];
#pragma unroll
        for (int i = 0; i < 4; ++i) {
          bfv[i] = *(const bf16x8*)(b_s + i * 16 * LDX + ks * 32);
          xf[i] = *(const bf16x8*)(x_s + i * 16 * LDX + ks * 32);
        }
#pragma unroll
        for (int pt = 0; pt < 4; ++pt)
#pragma unroll
          for (int nt = 0; nt < 4; ++nt)
            acc[pt][nt] = mma16<true>(bfv[nt], xf[pt], acc[pt][nt]);
      }
      u16* dst = S + ((((size_t)(dir * 4 + b) * NCH + chunk_scan_idx(dir, m)) * 16 + h) * 64) * 128;
#pragma unroll
      for (int pt = 0; pt < 4; ++pt)
#pragma unroll
        for (int nt = 0; nt < 4; ++nt) st_bf4(dst + (size_t)(pt * 16 + lr) * 128 + nh * 64 + nt * 16 + lq * 4, acc[pt][nt]);
    }
    __syncthreads();
  }
}

DI void phase_ssd_scan(const Params& p) {
  u16* S = (u16*)(p.ws + OFF_S);
  const float* chdec = (const float*)(p.ws + OFF_CHDEC);
  const int gtid = blockIdx.x * 256 + TIDX, gn = gridDim.x * 256;
  for (int i = gtid; i < 2 * 4 * 16 * 2048; i += gn) {
    const int e4 = i & 2047, h = (i >> 11) & 15, db = i >> 15;
    float hp[4] = {0.f, 0.f, 0.f, 0.f};
    u16* ptr = S + (((size_t)db * NCH) * 16 + h) * 8192 + e4 * 4;
    const float* dc = chdec + (db * NCH) * 16 + h;
    uint2 u[NCH];
#pragma unroll
    for (int c = 0; c < NCH; ++c) u[c] = *(const uint2*)(ptr + (size_t)c * 16 * 8192);
#pragma unroll
    for (int c = 0; c < NCH; ++c) {
      const float d = dc[c * 16];
      uint2 w;
      w.x = pk2(hp[0], hp[1]);
      w.y = pk2(hp[2], hp[3]);
      *(uint2*)(ptr + (size_t)c * 16 * 8192) = w;
      hp[0] = d * hp[0] + bflo(u[c].x);
      hp[1] = d * hp[1] + bfhi(u[c].x);
      hp[2] = d * hp[2] + bflo(u[c].y);
      hp[3] = d * hp[3] + bfhi(u[c].y);
    }
  }
}

DI void phase_ssd_y(const Params& p, int l, bool with_ctx, u16* smem) {
  const u16* XBC = (const u16*)(p.ws + OFF_XBC);
  const u16* S = (const u16*)(p.ws + OFF_S);
  u16* Yssd = (u16*)(p.ws + OFF_YSSD);
  u16* sB = smem;
  u16* sXt = smem + 128 * LDX;
  float* sw = (float*)(smem + 256 * LDX);
  float* scum = sw + 256;
  float* sdt = scum + 256;
  const int tid = TIDX, lane = tid & 63, wid = tid >> 6, lr = lane & 15, lq = lane >> 4;
  const int m_lo = with_ctx ? 0 : 2;
  const int nm = NCH - m_lo;
  for (int it = blockIdx.x; it < NBATCH * nm * 16; it += gridDim.x) {
    const int h = it & 15, m = m_lo + (it >> 4) % nm, b = it / (16 * nm);
    const int r0 = chunk_row0(b, m), g = h >> 3;
    if (wid < 2) {
      float tot;
      ssd_cums(p, l, h, r0, sw, scum, sdt, tot);
    }
    {
      const u16* hin0 = S + ((((size_t)(0 * 4 + b) * NCH + chunk_scan_idx(0, m)) * 16 + h) * 64) * 128;
      const u16* hin1 = S + ((((size_t)(1 * 4 + b) * NCH + chunk_scan_idx(1, m)) * 16 + h) * 64) * 128;
#pragma unroll
      for (int i = 0; i < 8; ++i) {
        const int id = tid + 256 * i, dir = id >> 10, rem = id & 1023, rr = rem >> 4, cc = rem & 15;
        *(uint4*)(sB + dir * 64 * LDX + rr * LDX + cc * 8) = *(const uint4*)((dir ? hin1 : hin0) + rr * 128 + cc * 8);
      }
    }
    const XRegs xr = ssd_load_x(XBC, r0, h);
    __syncthreads();
    ssd_write_xt(xr, sdt, sXt);
    f32x4 acc0[2][4], acc1[2][4];
#pragma unroll
    for (int qi = 0; qi < 2; ++qi) {
      const int q = wid * 32 + qi * 16 + lr;
      bf16x8 cf[4];
#pragma unroll
      for (int ks = 0; ks < 4; ++ks) cf[ks] = *(const bf16x8*)(XBC + (size_t)(r0 + q) * 1536 + 1280 + g * 128 + ks * 32 + lq * 8);
#pragma unroll
      for (int dir = 0; dir < 2; ++dir) {
        f32x4 t[4];
#pragma unroll
        for (int pt = 0; pt < 4; ++pt) t[pt] = (f32x4){0.f, 0.f, 0.f, 0.f};
#pragma unroll
        for (int ks = 0; ks < 4; ++ks)
#pragma unroll
          for (int pt = 0; pt < 4; ++pt) {
            const bf16x8 hf = *(const bf16x8*)(sB + dir * 64 * LDX + (pt * 16 + lr) * LDX + ks * 32 + lq * 8);
            t[pt] = mma16<true>(hf, cf[ks], t[pt]);
          }
        const float e = __expf(scum[dir * 128 + q]);
#pragma unroll
        for (int pt = 0; pt < 4; ++pt) { if (qi == 0) acc0[dir][pt] = t[pt] * e; else acc1[dir][pt] = t[pt] * e; }
      }
      __builtin_amdgcn_sched_barrier(0);
    }
    __syncthreads();
#pragma unroll
    for (int i = 0; i < 8; ++i) {
      const int id = tid + 256 * i, rr = id >> 4, cc = id & 15;
      *(uint4*)(sB + rr * LDX + cc * 8) = *(const uint4*)(XBC + (size_t)(r0 + rr) * 1536 + 1024 + g * 128 + cc * 8);
    }
    __syncthreads();
    const float dsk = p.d_skip[l * 16 + h];
#pragma unroll 1
    for (int qi = 0; qi < 2; ++qi) {
      const int q = wid * 32 + qi * 16 + lr;
      f32x4 acc[2][4];
#pragma unroll
      for (int dir = 0; dir < 2; ++dir)
#pragma unroll
        for (int pt = 0; pt < 4; ++pt)
#pragma unroll
          for (int j = 0; j < 4; ++j) acc[dir][pt][j] = qi == 0 ? acc0[dir][pt][j] : acc1[dir][pt][j];
      const float cq0 = scum[q], cq1 = scum[128 + q];
      bf16x8 cf[4];
#pragma unroll
      for (int ks = 0; ks < 4; ++ks) cf[ks] = *(const bf16x8*)(XBC + (size_t)(r0 + q) * 1536 + 1280 + g * 128 + ks * 32 + lq * 8);
#pragma unroll 1
      for (int u = 0; u < 4; ++u) {
        f32x4 sc[2];
#pragma unroll
        for (int half = 0; half < 2; ++half) {
          sc[half] = (f32x4){0.f, 0.f, 0.f, 0.f};
#pragma unroll
          for (int ks = 0; ks < 4; ++ks) {
            const bf16x8 bfv = *(const bf16x8*)(sB + ((2 * u + half) * 16 + lr) * LDX + ks * 32 + lq * 8);
            sc[half] = mma16<true>(bfv, cf[ks], sc[half]);
          }
        }
#pragma unroll
        for (int dir = 0; dir < 2; ++dir) {
          const float cq = dir == 0 ? cq0 : cq1;
          union { bf16x8 v; unsigned w[4]; } gp;
#pragma unroll
          for (int half = 0; half < 2; ++half) {
            const int k0 = (2 * u + half) * 16 + lq * 4;
            const f32x4 ck4 = *(const f32x4*)(scum + dir * 128 + k0);
            float gv[4];
#pragma unroll
            for (int j = 0; j < 4; ++j) {
              const int k = k0 + j;
              const bool ok = dir == 0 ? (k <= q) : (k >= q);
              const float arg = ok ? (cq - ck4[j]) * 1.4426950408889634f : -1.0e30f;
              gv[j] = sc[half][j] * __builtin_amdgcn_exp2f(arg);
            }
            gp.w[half * 2] = pk2(gv[0], gv[1]);
            gp.w[half * 2 + 1] = pk2(gv[2], gv[3]);
          }
#pragma unroll
          for (int pt = 0; pt < 4; ++pt) {
            union { bf16x8 v; uint2 hh[2]; } xf;
            const u16* xs = sXt + dir * 64 * LDX + (pt * 16 + lr) * LDX + u * 32 + lq * 4;
            xf.hh[0] = *(const uint2*)(xs);
            xf.hh[1] = *(const uint2*)(xs + 16);
            acc[dir][pt] = mma16<true>(xf.v, gp.v, acc[dir][pt]);
          }
        }
      }
#pragma unroll
      for (int pt = 0; pt < 4; ++pt) {
        const uint2 xu = *(const uint2*)(XBC + (size_t)(r0 + q) * 1536 + h * 64 + pt * 16 + lq * 4);
        f32x4 y = acc[0][pt] + acc[1][pt];
        y[0] += dsk * bflo(xu.x);
        y[1] += dsk * bfhi(xu.x);
        y[2] += dsk * bflo(xu.y);
        y[3] += dsk * bfhi(xu.y);
        st_bf4(Yssd + (size_t)(r0 + q) * 1024 + h * 64 + pt * 16 + lq * 4, y);
      }
    }
    __syncthreads();
  }
}

DI void phase_ssd_finish(const Params& p, int l, int nrows) {
  u16* Yssd = (u16*)(p.ws + OFF_YSSD);
  const u16* Z = (const u16*)(p.ws + OFF_Z);
  const float* g = p.g_ssd + l * 1024;
  const int lane = TIDX & 63;
  const int gw = (blockIdx.x * 256 + TIDX) >> 6, nw = (gridDim.x * 256) >> 6;
  for (int r = gw; r < nrows; r += nw) {
    float v[16];
    float ss = 0.f;
#pragma unroll
    for (int i = 0; i < 2; ++i) {
      const uint4 yu = *(const uint4*)(Yssd + (size_t)r * 1024 + i * 512 + lane * 8);
      const uint4 zu = *(const uint4*)(Z + (size_t)r * 1024 + i * 512 + lane * 8);
      const unsigned ya[4] = {yu.x, yu.y, yu.z, yu.w}, za[4] = {zu.x, zu.y, zu.z, zu.w};
#pragma unroll
      for (int k = 0; k < 4; ++k) {
        const float a = bflo(ya[k]) * siluf(bflo(za[k])), bb = bfhi(ya[k]) * siluf(bfhi(za[k]));
        v[i * 8 + 2 * k] = a;
        v[i * 8 + 2 * k + 1] = bb;
        ss += a * a + bb * bb;
      }
    }
    const float rstd = rsqrtf(wave_sum(ss) * (1.f / 1024.f) + EPS);
#pragma unroll
    for (int i = 0; i < 2; ++i) {
      const f32x4 g0 = *(const f32x4*)(g + i * 512 + lane * 8), g1 = *(const f32x4*)(g + i * 512 + lane * 8 + 4);
      uint4 o;
      o.x = pk2(v[i * 8 + 0] * rstd * g0[0], v[i * 8 + 1] * rstd * g0[1]);
      o.y = pk2(v[i * 8 + 2] * rstd * g0[2], v[i * 8 + 3] * rstd * g0[3]);
      o.z = pk2(v[i * 8 + 4] * rstd * g1[0], v[i * 8 + 5] * rstd * g1[1]);
      o.w = pk2(v[i * 8 + 6] * rstd * g1[2], v[i * 8 + 7] * rstd * g1[3]);
      *(uint4*)(Yssd + (size_t)r * 1024 + i * 512 + lane * 8) = o;
    }
  }
}

DI void phase_merge(const Params& p, int l, int nrows, const float* srcL, const float* srcC, u16* smem) {
  const u16* H = (const u16*)(p.ws + OFF_H2);
  const u16* W0 = (const u16*)(p.ws + OFF_W0);
  const float* modl = (const float*)(p.ws + OFF_MODV) + (size_t)l * 5 * 6144;
  const float* bg = p.b_gate + l * 3072;
  float* XC = (float*)(p.ws + OFF_XC);
  const int tid = TIDX, lane = tid & 63, wid = tid >> 6, wm = wid >> 1, wn = wid & 1, lr = lane & 15, lq = lane >> 4;
  const int MT = nrows / 128;
  XCD_TILE_LOOP(MT, 8) {
    int mt, nt;
    tile_xcd(j_, blockIdx.x & 7, MT >> 3, 8, mt, nt);
    const int n0 = nt * 128;
#pragma unroll 1
    for (int br = 0; br < 3; ++br) {
      const u16* Ybr = (const u16*)(p.ws + (br == 0 ? OFF_YMLA : (br == 1 ? OFF_YSSD : OFF_YGQA)));
      const int ldyb = br == 1 ? 1024 : 512, koffb = br == 0 ? 0 : (br == 1 ? 512 : 1536);
      f32x4 gt[4][4];
      zero_acc<4>(gt);
      gemm_core<4>(H + (size_t)mt * 128 * 1024, 1024, W0 + (size_t)(br * 1024 + n0) * 1024, 1024, 1024, gt, smem);
      uint2 gp[4][4];
#pragma unroll
      for (int ni = 0; ni < 4; ++ni) {
        const f32x4 bv = *(const f32x4*)(bg + br * 1024 + n0 + wn * 64 + ni * 16 + lq * 4);
#pragma unroll
        for (int mi = 0; mi < 4; ++mi) {
          gp[mi][ni].x = pk2(sigmf(gt[mi][ni][0] + bv[0]), sigmf(gt[mi][ni][1] + bv[1]));
          gp[mi][ni].y = pk2(sigmf(gt[mi][ni][2] + bv[2]), sigmf(gt[mi][ni][3] + bv[3]));
          asm volatile("" : "+v"(gp[mi][ni].x), "+v"(gp[mi][ni].y));
        }
      }
      f32x4 ya[4][4];
      zero_acc<4>(ya);
      gemm_core<4>(Ybr + (size_t)mt * 128 * ldyb, ldyb, W0 + W0_OUT + (size_t)n0 * 2048 + koffb, 2048, ldyb, ya, smem);
#pragma unroll
      for (int mi = 0; mi < 4; ++mi) {
        const int row = mt * 128 + wm * 64 + mi * 16 + lr;
        const float* src = row < TL ? srcL + (size_t)row * D : srcC + (size_t)(row - TL) * D;
        float* dst = row < TL ? p.out + (size_t)row * D : XC + (size_t)(row - TL) * D;
        const float* g1 = modl + row_mod(row) * 6144 + 2048;
#pragma unroll
        for (int ni = 0; ni < 4; ++ni) {
          const int col = n0 + wn * 64 + ni * 16 + lq * 4;
          const f32x4 gv = *(const f32x4*)(g1 + col);
          f32x4 base;
          if (br == 0) base = ALPHA * *(const f32x4*)(src + col);
          else base = *(const f32x4*)(dst + col);
          f32x4 gf;
          gf[0] = bflo(gp[mi][ni].x); gf[1] = bfhi(gp[mi][ni].x); gf[2] = bflo(gp[mi][ni].y); gf[3] = bfhi(gp[mi][ni].y);
          *(f32x4*)(dst + col) = base + gv * (gf * ya[mi][ni]);
        }
        __builtin_amdgcn_sched_barrier(0);
      }
    }
  }
}

DI void phase_ffn_in(const Params& p, int nrows, u16* smem) {
  const u16* H = (const u16*)(p.ws + OFF_H2);
  const u16* W0 = (const u16*)(p.ws + OFF_W0);
  u16* ACT = (u16*)(p.ws + OFF_ACT);
  const int tid = TIDX, lane = tid & 63, wid = tid >> 6, wm = wid >> 1, wn = wid & 1, lr = lane & 15, lq = lane >> 4;
  const int MT = nrows / 128;
  XCD_TILE_LOOP(MT, 44) {
    int mt, nt;
    tile_xcd(j_, blockIdx.x & 7, MT >> 3, 44, mt, nt);
    f32x4 acc[4][4];
    zero_acc<4>(acc);
    gemm_core<4, true>(H + (size_t)mt * 128 * 1024, 1024, W0 + (size_t)nt * 128 * 1024, 1024, 1024, acc, smem);
#pragma unroll
    for (int mi = 0; mi < 4; ++mi) {
      const int row = mt * 128 + wm * 64 + mi * 16 + lr;
#pragma unroll
      for (int pr = 0; pr < 2; ++pr) {
        const int q = (nt * 128 + wn * 64 + pr * 32) >> 5;
        f32x4 v;
#pragma unroll
        for (int j = 0; j < 4; ++j) v[j] = siluf(acc[mi][2 * pr][j]) * acc[mi][2 * pr + 1][j];
        st_h4(ACT + (size_t)row * FFN_H + q * 16 + lq * 4, v);
      }
    }
  }
}

DI void phase_ffn_out(const Params& p, int l, int nrows, u16* smem) {
  const u16* ACT = (const u16*)(p.ws + OFF_ACT);
  const u16* W1 = (const u16*)(p.ws + OFF_W1);
  const float* modl = (const float*)(p.ws + OFF_MODV) + (size_t)l * 5 * 6144;
  float* XC = (float*)(p.ws + OFF_XC);
  const int tid = TIDX, lane = tid & 63, wid = tid >> 6, wm = wid >> 1, wn = wid & 1, lr = lane & 15, lq = lane >> 4;
  const int MT = nrows / 128;
  XCD_TILE_LOOP(MT, 8) {
    int mt, nt;
    tile_xcd(j_, blockIdx.x & 7, MT >> 3, 8, mt, nt);
    f32x4 acc[4][4];
    zero_acc<4>(acc);
    gemm_core<4, true>(ACT + (size_t)mt * 128 * FFN_H, FFN_H, W1 + (size_t)nt * 128 * FFN_H, FFN_H, FFN_H, acc, smem);
#pragma unroll
    for (int mi = 0; mi < 4; ++mi) {
      const int row = mt * 128 + wm * 64 + mi * 16 + lr;
      float* xp = row < TL ? p.out + (size_t)row * D : XC + (size_t)(row - TL) * D;
      const float* g2 = modl + row_mod(row) * 6144 + 5120;
#pragma unroll
      for (int ni = 0; ni < 4; ++ni) {
        const int col = nt * 128 + wn * 64 + ni * 16 + lq * 4;
        const f32x4 xv = *(const f32x4*)(xp + col), gv = *(const f32x4*)(g2 + col);
        *(f32x4*)(xp + col) = ALPHA * xv + gv * acc[mi][ni];
      }
    }
  }
}

#define XB_TMO      128
#define XB_XCNT(j)  (256  + 64 * (j))
#define XB_XSUB(j)  (1280 + 64 * (j))
#define XB_XGEN(j)  (2304 + 64 * (j))
#define XB_TOP      3328
#define XB_TOPGEN   3392
#define XCD_BAR_WORDS 3456
#define XB_SPIN_CAP (1u << 20)
#define LAS __attribute__((address_space(3)))
DI unsigned xb_ld(unsigned* p) { return __hip_atomic_load(p, __ATOMIC_RELAXED, __HIP_MEMORY_SCOPE_AGENT); }
DI unsigned xb_add(unsigned* p, unsigned v) { return __hip_atomic_fetch_add(p, v, __ATOMIC_RELAXED, __HIP_MEMORY_SCOPE_AGENT); }
DI unsigned xb_xcc_id() { return (unsigned)__builtin_amdgcn_s_getreg((3 << 11) | 20) & 0xFu; }
#define XB_SPIN(cond, bar) do { unsigned _sp = 0; while (cond) { __builtin_amdgcn_s_sleep(1); \
    if ((++_sp & 255u) == 0u) { if (xb_ld(&(bar)[XB_TMO])) break; if (_sp > XB_SPIN_CAP) { atomicAdd(&(bar)[XB_TMO], 1u); break; } } } } while (0)
struct XcdBarrier { unsigned* bar; unsigned x; volatile LAS unsigned* st; };
DI XcdBarrier xcd_barrier_post(unsigned* bar, volatile LAS unsigned* st) {
  XcdBarrier b; b.bar = bar; b.x = xb_xcc_id(); b.st = st;
  if (threadIdx.x == 0) (void)xb_add(&bar[XB_XCNT(b.x)], 1u);
  return b;
}
DI void xcd_barrier_complete(unsigned* bar, unsigned x, unsigned& nloc, unsigned& nx) {
  const unsigned G = gridDim.x * gridDim.y * gridDim.z;
  unsigned sum, cnt, mine, sp = 0u;
  for (;;) {
    sum = 0u; cnt = 0u; mine = 0u;
#pragma unroll
    for (unsigned j = 0; j < 16; ++j) { const unsigned c = xb_ld(&bar[XB_XCNT(j)]); sum += c; cnt += (c > 0u) ? 1u : 0u; mine = (j == x) ? c : mine; }
    if (sum == G) break;
    __builtin_amdgcn_s_sleep(1);
    if ((++sp & 255u) == 0u) { if (xb_ld(&bar[XB_TMO])) break; if (sp > XB_SPIN_CAP) { atomicAdd(&bar[XB_TMO], 1u); break; } }
  }
  nloc = mine > 0u ? mine : 1u; nx = cnt > 0u ? cnt : 1u;
}
DI void xcd_barrier(const XcdBarrier& b) {
  asm volatile("s_waitcnt vmcnt(0)" ::: "memory");
  __syncthreads();
  if (threadIdx.x == 0) {
    unsigned* bar = b.bar;
    __builtin_amdgcn_s_waitcnt(0);
    unsigned nloc = b.st[0], nx = b.st[1];
    if (nloc == 0u) { xcd_barrier_complete(bar, b.x, nloc, nx); b.st[0] = nloc; b.st[1] = nx; }
    const unsigned old = xb_add(&bar[XB_XSUB(b.x)], 1u);
    const unsigned gen = old / nloc;
    if (old + 1u == (gen + 1u) * nloc) {
      __builtin_amdgcn_fence(__ATOMIC_RELEASE, "agent");
      asm volatile("s_waitcnt vmcnt(0)" ::: "memory");
      const unsigned og = xb_add(&bar[XB_TOP], 1u);
      const unsigned tg = og / nx;
      if (og + 1u == (tg + 1u) * nx) xb_add(&bar[XB_TOPGEN], 1u);
      else XB_SPIN(xb_ld(&bar[XB_TOPGEN]) == tg, bar);
      __builtin_amdgcn_fence(__ATOMIC_ACQUIRE, "agent");
      xb_add(&bar[XB_XGEN(b.x)], 1u);
      asm volatile("s_waitcnt vmcnt(0)" ::: "memory");
    } else {
      XB_SPIN(xb_ld(&bar[XB_XGEN(b.x)]) == gen, bar);
      __builtin_amdgcn_fence(__ATOMIC_ACQUIRE, "agent");
      asm volatile("s_waitcnt vmcnt(0)" ::: "memory");
    }
  }
  __syncthreads();
}

constexpr int NPHASE = 2 + 13 * 2;

__global__ void __launch_bounds__(256, 2) fwd_megakernel(Params p) {
  __shared__ __attribute__((aligned(16))) unsigned char smem_raw[SMEM_BYTES];
  u16* smem = (u16*)smem_raw;
  float* smf = (float*)smem_raw;
  cg::grid_group grid = cg::this_grid();
  __shared__ uint4 xb_words;
  if (threadIdx.x == 0) xb_words = make_uint4(0u, 0u, 0u, 0u);
  __syncthreads();
  XcdBarrier xb = xcd_barrier_post((unsigned*)(p.ws + OFF_BAR), (volatile LAS unsigned*)&xb_words);
  if (p.ph0 < 0) grid.sync();
  const float* modv = (const float*)(p.ws + OFF_MODV);
  float* XC = (float*)(p.ws + OFF_XC);
  for (int ph = p.ph0; ph < p.ph1; ++ph) {
    if (ph == 0) {
      phase_prologue(p, smf);
      cvt_inproj_set(p, 0, smf);
    } else if (ph == 1) {
      ln_rows<0>(p, T, p.x, p.ctx, nullptr, nullptr, nullptr, nullptr, modv, 0, 1024, (u16*)(p.ws + OFF_H), true);
    } else {
      const int l = (ph - 2) / 13, s = (ph - 2) % 13;
      const bool with_ctx = (l == 0);
      const int nrows = with_ctx ? T : TL;
      const float* modl = modv + (size_t)l * 5 * 6144;
      const float* srcL = (l == 0) ? p.x : p.out;
      const float* srcC = (l == 0) ? p.ctx : XC;
      switch (s) {
        case 0: phase_inproj(p, l, smem); break;
        case 1: phase_c1(p, l); break;
        case 2: phase_c2(p, l, smem); break;
        case 3: phase_attn(p, l, with_ctx, smem); break;
        case 4: phase_ssd_states(p, l, smem); break;
        case 5: phase_ssd_scan(p); cvt_merge_set(p, l, smf); break;
        case 6: phase_ssd_y(p, l, with_ctx, smem); break;
        case 7:
          phase_ssd_finish(p, l, nrows);
          ln_rows<0>(p, nrows, srcL, srcC, nullptr, nullptr, nullptr, nullptr, modl, 0, 1024, (u16*)(p.ws + OFF_H2), true);
          break;
        case 8: phase_merge(p, l, nrows, srcL, srcC, smem); break;
        case 9:
          ln_rows<1>(p, nrows, p.out, XC, p.out, XC, p.ln1_g + l * D, p.ln1_b + l * D, modl, 3072, 4096, (u16*)(p.ws + OFF_H2), true, true);
          cvt_ffn_set(p, l, smf);
          break;
        case 10: phase_ffn_in(p, nrows, smem); break;
        case 11: phase_ffn_out(p, l, nrows, smem); break;
        case 12:
          if (l == 0) {
            ln_rows<1>(p, nrows, p.out, XC, p.out, XC, p.ln2_g + l * D, p.ln2_b + l * D, modv + (size_t)5 * 6144, 0, 1024, (u16*)(p.ws + OFF_H), true);
            cvt_inproj_set(p, 1, smf);
          } else {
            ln_rows<1>(p, nrows, p.out, XC, p.out, XC, p.ln2_g + l * D, p.ln2_b + l * D, modl, 0, 1024, nullptr, false);
          }
          break;
      }
    }
    if (ph + 1 < p.ph1) xcd_barrier(xb);
  }
#ifdef DBG_N
  grid.sync();
  {
    const u16* w16 = (const u16*)p.ws;
    const size_t n16 = WS_END / 2;
    const int gtid = blockIdx.x * 256 + TIDX, gn = gridDim.x * 256;
    for (int i = gtid; i < TL * D; i += gn) {
      unsigned s = 0;
      for (int j = 0; j < 8; ++j) {
        const size_t a = (size_t)i + (size_t)j * (size_t)(TL * D);
        if (a < n16) s += w16[a] * (unsigned)(j + 1);
      }
      p.out[i] = (float)(s & 0xFFFFFu);
    }
  }
#endif
}

extern "C" void kernel_launch(void* const* d_in, const int* in_sizes, int n_in, void* d_out, int out_size, void* d_ws,
                              size_t ws_size, hipStream_t stream) {
  static int grid_blocks = 0;
  if (!grid_blocks) {
    int dev = 0, cus = 0, per_cu = 0;
    (void)hipGetDevice(&dev);
    (void)hipDeviceGetAttribute(&cus, hipDeviceAttributeMultiprocessorCount, dev);
    (void)hipOccupancyMaxActiveBlocksPerMultiprocessor(&per_cu, fwd_megakernel, 256, 0);
    if (per_cu > 2) per_cu = 2;
    if (per_cu < 1) per_cu = 1;
    grid_blocks = cus * per_cu;
  }
  if (n_in != 27 || ws_size < WS_TOTAL || out_size != TL * D) {
    fprintf(stderr, "kernel_launch: unexpected shapes (n_in %d, out %d, ws %zu < %zu)\n", n_in, out_size, ws_size, (size_t)WS_END);
    return;
  }
  Params p{};
  const float** pp = (const float**)&p;
  for (int i = 0; i < 27; ++i) pp[i] = (const float*)d_in[i];
  p.out = (float*)d_out;
  p.ws = (char*)d_ws;
  p.ph0 = 0;
#ifdef DBG_N
  p.ph1 = DBG_N;
#else
  p.ph1 = NPHASE;
#endif
  (void)hipMemsetAsync((char*)d_ws + OFF_BAR, 0, XCD_BAR_WORDS * 4, stream);
  void* args[] = {&p};
  hipError_t e = hipLaunchCooperativeKernel((void*)fwd_megakernel, dim3(grid_blocks), dim3(256), args, 0, stream);
  if (e != hipSuccess) fprintf(stderr, "cooperative launch failed: %s (grid %d)\n", hipGetErrorString(e), grid_blocks);
}
```

```cpp
#include <hip/hip_runtime.h>
#include <hip/hip_cooperative_groups.h>
#include <cstdio>
namespace cg = cooperative_groups;

typedef unsigned short u16;
typedef __attribute__((ext_vector_type(8))) short bf16x8;
typedef __attribute__((ext_vector_type(4))) float f32x4;
#define DI __device__ __forceinline__

constexpr int D = 1024, NBATCH = 4, SEQ = 4096, CTXL = 256;
constexpr int TL = NBATCH * SEQ, TC = NBATCH * CTXL, T = TL + TC;
constexpr int NKEY = CTXL + SEQ;
constexpr int NCH = 34;
constexpr int IN_W = 7104, FFN_H = 2816;
constexpr int WINP = 4224;
constexpr float EPS = 1e-6f;
constexpr float ALPHA = 1.41421356237f;

constexpr size_t OFF_MODV = 0;
constexpr size_t OFF_COSM = OFF_MODV + 2 * 5 * 6144 * 4;
constexpr size_t OFF_SINM = OFF_COSM + 4096 * 16 * 4;
constexpr size_t OFF_COSG = OFF_SINM + 4096 * 16 * 4;
constexpr size_t OFF_SING = OFF_COSG + 4096 * 32 * 4;
constexpr size_t OFF_STATS = OFF_SING + 4096 * 32 * 4;
constexpr size_t OFF_CHDEC = OFF_STATS + (size_t)T * 2 * 4;
constexpr size_t OFF_XC = OFF_CHDEC + 2 * 4 * 34 * 16 * 4;
constexpr size_t OFF_W0 = OFF_XC + (size_t)TC * D * 4;
constexpr size_t OFF_W1 = OFF_W0 + (size_t)5632 * 1024 * 2;
constexpr size_t OFF_VTG = OFF_W1 + (size_t)1024 * 2816 * 2;
constexpr size_t OFF_R0 = OFF_VTG + (size_t)4 * 2 * 64 * NKEY * 2;
constexpr size_t SZ_T1024 = (size_t)T * 1024 * 2;
constexpr size_t SZ_XBC = (size_t)T * 1536 * 2;
constexpr size_t OFF_R1 = OFF_R0 + SZ_T1024 + SZ_XBC;
constexpr size_t OFF_R2 = OFF_R1 + SZ_T1024;
constexpr size_t OFF_R3 = OFF_R2 + SZ_XBC;
constexpr size_t OFF_R4 = OFF_R3 + (size_t)T * 32 * 4;
constexpr size_t OFF_BAR = OFF_R4 + SZ_XBC;
constexpr size_t WS_END = OFF_R4 + SZ_XBC;
constexpr size_t WS_TOTAL = OFF_BAR + 16384;
constexpr size_t OFF_H = OFF_R0;
constexpr size_t OFF_XR = OFF_R0 + SZ_T1024;
constexpr size_t OFF_QM = OFF_R0;
constexpr size_t OFF_KM = OFF_QM + (size_t)T * 768 * 2;
constexpr size_t OFF_VTM = OFF_KM + (size_t)T * 768 * 2;
constexpr size_t OFF_YMLA = OFF_VTM + (size_t)T * 512 * 2;
constexpr size_t OFF_S = OFF_R0;
constexpr size_t OFF_ACT = OFF_R0;
constexpr size_t OFF_Z = OFF_R1;
constexpr size_t OFF_XBC = OFF_R2;
constexpr size_t OFF_H2 = OFF_R2;
constexpr size_t OFF_DT = OFF_R3;
constexpr size_t OFF_PGQA = OFF_R4;
constexpr size_t OFF_PMLA = OFF_R4 + (size_t)T * 640 * 2;
constexpr size_t OFF_YGQA = OFF_R4 + SZ_T1024;
constexpr size_t OFF_YSSD = OFF_R4;
static_assert(OFF_YMLA + (size_t)T * 512 * 2 == OFF_R1, "R0 layout");
static_assert(OFF_PMLA + (size_t)T * 672 * 2 <= WS_END, "R4 layout");
static_assert(OFF_YGQA + (size_t)T * 512 * 2 == WS_END, "R4 layout");
static_assert((size_t)2 * 4 * 34 * 16 * 64 * 128 * 2 <= (size_t)T * (768 + 768 + 512) * 2, "S fits");
static_assert(OFF_ACT + (size_t)T * 2816 * 2 <= OFF_R2, "ACT fits");
constexpr size_t W0_UQ = (size_t)WINP * 1024;
constexpr size_t W0_UKV = W0_UQ + (size_t)768 * 384;
constexpr size_t W0_OUT = (size_t)3072 * 1024;

constexpr int SMEM_BYTES = 73728;

struct Params {
  const float *x, *c, *ctx, *c_ctx, *w_mod, *b_mod, *w_in, *b_gate, *w_uq, *g_q_mla, *w_ukv, *g_kv_mla, *conv_w,
      *conv_b, *a_log, *dt_bias, *d_skip, *g_ssd, *g_q_gqa, *g_k_gqa, *w_out, *ln1_g, *ln1_b, *w_ffn_in, *w_ffn_out,
      *ln2_g, *ln2_b;
  float* out;
  char* ws;
  int ph0, ph1;
};

DI int threadIdx_x_raw() { return (int)__builtin_amdgcn_workitem_id_x(); }
DI int opaque_tid() { int t = threadIdx_x_raw(); asm volatile("" : "+v"(t)); return t; }
#define TIDX opaque_tid()
typedef _Float16 f16x2_t __attribute__((ext_vector_type(2)));
typedef _Float16 f16x8_t __attribute__((ext_vector_type(8)));
DI float bflo(unsigned w) { return (float)__builtin_bit_cast(f16x2_t, w)[0]; }
DI float bfhi(unsigned w) { return (float)__builtin_bit_cast(f16x2_t, w)[1]; }
DI float bf2f(u16 h) { return bflo((unsigned)h); }
typedef __bf16 bf16x2_t __attribute__((ext_vector_type(2)));
typedef float f32x2_t __attribute__((ext_vector_type(2)));
DI unsigned pk2(float lo, float hi) {
  f32x2_t f = {lo, hi};
  f16x2_t b = __builtin_convertvector(f, f16x2_t);
  return __builtin_bit_cast(unsigned, b);
}
DI u16 f2bf(float f) { return (u16)(pk2(f, 0.f) & 0xffffu); }
DI unsigned pkh2(float lo, float hi) {
  f32x2_t f = {lo, hi};
  f16x2_t b = __builtin_convertvector(f, f16x2_t);
  return __builtin_bit_cast(unsigned, b);
}
DI u16 f2h(float f) { return (u16)(pkh2(f, 0.f) & 0xffffu); }
DI float siluf(float x) { return x / (1.f + __expf(-x)); }
DI float sigmf(float x) { return 1.f / (1.f + __expf(-x)); }
DI void st_bf4(u16* p, f32x4 v) {
  uint2 u;
  u.x = pk2(v[0], v[1]);
  u.y = pk2(v[2], v[3]);
  *(uint2*)p = u;
}
DI void st_h4(u16* p, f32x4 v) {
  uint2 u;
  u.x = pkh2(v[0], v[1]);
  u.y = pkh2(v[2], v[3]);
  *(uint2*)p = u;
}
template <bool F16>
DI f32x4 mma16(bf16x8 a, bf16x8 b, f32x4 c) {
  return __builtin_amdgcn_mfma_f32_16x16x32_f16(__builtin_bit_cast(f16x8_t, a), __builtin_bit_cast(f16x8_t, b), c, 0, 0, 0);
}
DI int row_mod(int r) { return r < TL ? (r >> 12) : 4; }
DI int row_batch(int r) { return r < TL ? (r >> 12) : ((r - TL) >> 8); }
DI int row_key(int r) { return r < TL ? CTXL + (r & 4095) : ((r - TL) & 255); }
DI float quad_max(float v) {
  auto r = __builtin_amdgcn_permlane16_swap(__float_as_uint(v), __float_as_uint(v), false, false);
  v = fmaxf(__uint_as_float(r[0]), __uint_as_float(r[1]));
  auto s = __builtin_amdgcn_permlane32_swap(__float_as_uint(v), __float_as_uint(v), false, false);
  return fmaxf(__uint_as_float(s[0]), __uint_as_float(s[1]));
}
DI float quad_sum(float v) {
  auto r = __builtin_amdgcn_permlane16_swap(__float_as_uint(v), __float_as_uint(v), false, false);
  v = __uint_as_float(r[0]) + __uint_as_float(r[1]);
  auto s = __builtin_amdgcn_permlane32_swap(__float_as_uint(v), __float_as_uint(v), false, false);
  return __uint_as_float(s[0]) + __uint_as_float(s[1]);
}
DI float wave_sum(float v) {
#pragma unroll
  for (int o = 32; o > 0; o >>= 1) v += __shfl_xor(v, o);
  return v;
}

#define GAS __attribute__((address_space(1)))
#define LAS3 __attribute__((address_space(3)))
template <int NI, bool F16 = false>
DI void gemm_core(const u16* __restrict__ A, int lda, const u16* __restrict__ B, int ldb, int K, f32x4 (&acc)[4][NI],
                  u16* smem) {
  constexpr int BN = 32 * NI;
  constexpr int NBL = BN / 32;
  char* sA = (char*)smem;
  char* sB = sA + 2 * 16384;
  const int tid = TIDX, lane = tid & 63, wid = tid >> 6, wm = wid >> 1, wn = wid & 1;
  const int lr = lane & 15, lq = lane >> 4;
  const int r8 = tid >> 3, gc = (tid & 7) ^ (r8 & 7);
  const int wq = __builtin_amdgcn_readfirstlane(wid) * 1024;
  const u16* Ap = A + (size_t)r8 * lda + gc * 8;
  const u16* Bp = B + (size_t)r8 * ldb + gc * 8;
  const int nk = K >> 6;
#define GEMM_ISSUE(KT, BUF)                                                                                         \
  {                                                                                                                 \
    const int ko_ = (KT) * 64;                                                                                      \
    _Pragma("unroll") for (int i = 0; i < 4; ++i)                                                                   \
        __builtin_amdgcn_global_load_lds((const GAS unsigned*)(Ap + (size_t)(32 * i) * lda + ko_),                  \
                                         (LAS3 unsigned*)(sA + (BUF) * 16384 + i * 4096 + wq), 16, 0, 0);           \
    _Pragma("unroll") for (int i = 0; i < NBL; ++i)                                                                 \
        __builtin_amdgcn_global_load_lds((const GAS unsigned*)(Bp + (size_t)(32 * i) * ldb + ko_),                  \
                                         (LAS3 unsigned*)(sB + (BUF) * (BN * 128) + i * 4096 + wq), 16, 0, 0);       \
  }
  GEMM_ISSUE(0, 0)
  asm volatile("s_waitcnt vmcnt(0)" ::: "memory");
  __builtin_amdgcn_s_barrier();
  const int x0 = ((0 + lq) ^ (lr & 7)) << 4, x1 = ((4 + lq) ^ (lr & 7)) << 4;
  const unsigned la = (unsigned)(size_t)((LAS3 char*)(sA + (wm * 64 + lr) * 128));
  const unsigned lb = (unsigned)(size_t)((LAS3 char*)(sB + (wn * 16 * NI + lr) * 128));
  const unsigned la0 = la + x0, la1 = la + x1, lb0 = lb + x0, lb1 = lb + x1;
#define LDSR(dst, addr, off) asm volatile("ds_read_b128 %0, %1 offset:%2" : "=v"(dst) : "v"(addr), "n"(off))
#define GEMM_HALF(BUF, LA, LB)                                                                             \
  {                                                                                                        \
    bf16x8 a0[4], b0[NI];                                                                                  \
    LDSR(a0[0], LA, (BUF) * 16384 + 0 * 2048); LDSR(a0[1], LA, (BUF) * 16384 + 1 * 2048);                  \
    LDSR(a0[2], LA, (BUF) * 16384 + 2 * 2048); LDSR(a0[3], LA, (BUF) * 16384 + 3 * 2048);                  \
    LDSR(b0[0], LB, (BUF) * (BN * 128) + 0 * 2048); LDSR(b0[1], LB, (BUF) * (BN * 128) + 1 * 2048);        \
    if (NI == 4) { LDSR(b0[NI - 2], LB, (BUF) * (BN * 128) + 2 * 2048); LDSR(b0[NI - 1], LB, (BUF) * (BN * 128) + 3 * 2048); } \
    if (NI == 4) asm volatile("s_waitcnt lgkmcnt(0)" : "+v"(a0[0]), "+v"(a0[1]), "+v"(a0[2]), "+v"(a0[3]), "+v"(b0[0]), "+v"(b0[1]), "+v"(b0[NI - 2]), "+v"(b0[NI - 1])); \
    else asm volatile("s_waitcnt lgkmcnt(0)" : "+v"(a0[0]), "+v"(a0[1]), "+v"(a0[2]), "+v"(a0[3]), "+v"(b0[0]), "+v"(b0[1])); \
    _Pragma("unroll") for (int mi = 0; mi < 4; ++mi)                                                       \
        _Pragma("unroll") for (int ni = 0; ni < NI; ++ni)                                                  \
            acc[mi][ni] = mma16<F16>(b0[ni], a0[mi], acc[mi][ni]);                                         \
  }
#define GEMM_COMPUTE(BUF) GEMM_HALF(BUF, la0, lb0) GEMM_HALF(BUF, la1, lb1)
  for (int kt = 0; kt < nk; kt += 2) {
    GEMM_ISSUE(kt + 1, 1)
    GEMM_COMPUTE(0)
    asm volatile("s_waitcnt vmcnt(0)" ::: "memory");
    __builtin_amdgcn_s_barrier();
    if (kt + 2 < nk) GEMM_ISSUE(kt + 2, 0)
    GEMM_COMPUTE(1)
    asm volatile("s_waitcnt vmcnt(0)" ::: "memory");
    __builtin_amdgcn_s_barrier();
  }
#undef GEMM_COMPUTE
#undef GEMM_HALF
#undef LDSR
#undef GEMM_ISSUE
}

template <int NI>
DI void zero_acc(f32x4 (&acc)[4][NI]) {
#pragma unroll
  for (int i = 0; i < 4; ++i)
#pragma unroll
    for (int j = 0; j < NI; ++j) acc[i][j] = (f32x4){0.f, 0.f, 0.f, 0.f};
}

DI void tile_xcd(int j, int x, int mc, int NT, int& mt, int& nt) {
  const int h0 = (mc + 3) >> 2;
  const int per = h0 * NT, blk = j / per, rem = j - blk * per;
  const int hb = (mc - blk * h0) < h0 ? (mc - blk * h0) : h0;
  const int ml = blk * h0 + rem % hb;
  nt = rem / hb;
  mt = ml * 8 + x;
}
#define XCD_TILE_LOOP(MT_, NT_) for (int j_ = blockIdx.x >> 3; j_ < ((MT_) >> 3) * (NT_); j_ += gridDim.x >> 3)
DI void tile_mn(int t, int MT, int NT, int& mt, int& nt) {
  const int per = 16 * NT;
  const int grp = t / per, rem = t - grp * per;
  const int gsz = (MT - grp * 16) < 16 ? (MT - grp * 16) : 16;
  mt = grp * 16 + rem % gsz;
  nt = rem / gsz;
}

struct MapIdent { int base; DI int operator()(int r) const { return base + r; } };
struct MapInproj {
  DI int operator()(int r) const {
    if (r < 768) return r < 672 ? r : -1;
    if (r < 1792) return 672 + (r - 768);
    if (r < 3328) return 1696 + (r - 1792);
    if (r < 3456) return (r - 3328) < 32 ? 3232 + (r - 3328) : -1;
    return 3264 + (r - 3456);
  }
};
struct MapFfnIn {
  DI int operator()(int r) const {
    const int q = r >> 5, s = r & 31;
    return s < 16 ? 16 * q + s : FFN_H + 16 * q + (s - 16);
  }
};
template <class Map, bool F16 = false>
DI void cvt_tile(const float* __restrict__ src, int ldsrc, u16* __restrict__ dst, int K, int r0, int k0,
                 const float* kscale, Map map, float* tile) {
  const int tid = TIDX;
  {
    const int rl = tid & 63;
    const int sc = map(r0 + rl);
#pragma unroll 4
    for (int i = 0; i < 16; ++i) {
      const int kl = (tid >> 6) + 4 * i;
      tile[kl * 65 + rl] = sc >= 0 ? src[(size_t)(k0 + kl) * ldsrc + sc] : 0.f;
    }
  }
  __syncthreads();
  {
    const int kl = tid & 63;
    const float s = kscale ? kscale[k0 + kl] : 1.f;
#pragma unroll 4
    for (int i = 0; i < 16; ++i) {
      const int rl = (tid >> 6) + 4 * i;
      dst[(size_t)(r0 + rl) * K + k0 + kl] = F16 ? f2h(tile[kl * 65 + rl] * s) : f2bf(tile[kl * 65 + rl] * s);
    }
  }
  __syncthreads();
}
DI void cvt_inproj_set(const Params& p, int l, float* tile) {
  u16* W0 = (u16*)(p.ws + OFF_W0);
  constexpr int N1 = (WINP / 64) * 16, N2 = (768 / 64) * (384 / 64), N3 = (1024 / 64) * (256 / 64);
  for (int it = blockIdx.x; it < N1 + N2 + N3; it += gridDim.x) {
    if (it < N1) {
      cvt_tile(p.w_in + (size_t)l * 1024 * IN_W, IN_W, W0, 1024, (it >> 4) * 64, (it & 15) * 64, nullptr, MapInproj(), tile);
    } else if (it < N1 + N2) {
      const int j = it - N1;
      cvt_tile(p.w_uq + (size_t)l * 384 * 768, 768, W0 + W0_UQ, 384, (j / 6) * 64, (j % 6) * 64, p.g_q_mla + l * 384, MapIdent{0}, tile);
    } else {
      const int j = it - N1 - N2;
      cvt_tile(p.w_ukv + (size_t)l * 256 * 1024, 1024, W0 + W0_UKV, 256, (j >> 2) * 64, (j & 3) * 64, p.g_kv_mla + l * 256, MapIdent{0}, tile);
    }
  }
}
DI void cvt_merge_set(const Params& p, int l, float* tile) {
  u16* W0 = (u16*)(p.ws + OFF_W0);
  constexpr int N1 = (3072 / 64) * 16, N2 = (1024 / 64) * (2048 / 64);
  for (int it = blockIdx.x; it < N1 + N2; it += gridDim.x) {
    if (it < N1) {
      cvt_tile(p.w_in + (size_t)l * 1024 * IN_W, IN_W, W0, 1024, (it >> 4) * 64, (it & 15) * 64, nullptr, MapIdent{4032}, tile);
    } else {
      const int j = it - N1;
      cvt_tile(p.w_out + (size_t)l * 2048 * 1024, 1024, W0 + W0_OUT, 2048, (j >> 5) * 64, (j & 31) * 64, nullptr, MapIdent{0}, tile);
    }
  }
}
DI void cvt_ffn_set(const Params& p, int l, float* tile) {
  u16* W0 = (u16*)(p.ws + OFF_W0);
  u16* W1 = (u16*)(p.ws + OFF_W1);
  constexpr int N1 = (5632 / 64) * 16, N2 = (1024 / 64) * (2816 / 64);
  for (int it = blockIdx.x; it < N1 + N2; it += gridDim.x) {
    if (it < N1) {
      cvt_tile<MapFfnIn, true>(p.w_ffn_in + (size_t)l * 1024 * 5632, 5632, W0, 1024, (it >> 4) * 64, (it & 15) * 64, nullptr, MapFfnIn(), tile);
    } else {
      const int j = it - N1;
      cvt_tile<MapIdent, true>(p.w_ffn_out + (size_t)l * 2816 * 1024, 1024, W1, 2816, (j / 44) * 64, (j % 44) * 64, nullptr, MapIdent{0}, tile);
    }
  }
}

DI void phase_prologue(const Params& p, float* smf) {
  const int tid = TIDX;
  float* sc = smf;
  float* red = smf + 5 * 1024;
  for (int i = tid; i < 5 * 1024; i += 256) {
    const int r = i >> 10, k = i & 1023;
    const float v = r < 4 ? p.c[r * 1024 + k] : p.c_ctx[k];
    sc[i] = siluf(v);
  }
  __syncthreads();
  float* modv = (float*)(p.ws + OFF_MODV);
  for (int it = blockIdx.x; it < 2 * 192; it += gridDim.x) {
    const int l = it / 192, n0 = (it % 192) * 32;
    const int col = tid & 31, kg = tid >> 5;
    float a[5] = {0.f, 0.f, 0.f, 0.f, 0.f};
    const float* w = p.w_mod + (size_t)l * 1024 * 6144 + n0 + col;
    for (int k = kg * 128; k < kg * 128 + 128; ++k) {
      const float wv = w[(size_t)k * 6144];
#pragma unroll
      for (int r = 0; r < 5; ++r) a[r] += sc[r * 1024 + k] * wv;
    }
#pragma unroll
    for (int r = 0; r < 5; ++r) red[(kg * 5 + r) * 32 + col] = a[r];
    __syncthreads();
    if (tid < 160) {
      const int r = tid >> 5, cl = tid & 31;
      float s = p.b_mod[l * 6144 + n0 + cl];
#pragma unroll
      for (int g = 0; g < 8; ++g) s += red[(g * 5 + r) * 32 + cl];
      modv[(l * 5 + r) * 6144 + n0 + cl] = s;
    }
    __syncthreads();
  }
  float* cosM = (float*)(p.ws + OFF_COSM);
  float* sinM = (float*)(p.ws + OFF_SINM);
  float* cosG = (float*)(p.ws + OFF_COSG);
  float* sinG = (float*)(p.ws + OFF_SING);
  const int gtid = blockIdx.x * 256 + tid, gn = gridDim.x * 256;
  for (int i = gtid; i < 4096 * 48; i += gn) {
    const int pos = i / 48, j = i % 48;
    const int prow = pos >> 6, pcol = pos & 63;
    float ang;
    if (j < 16) {
      const int f = j & 7;
      const float inv = exp2f(-(float)f * (13.287712379549449f / 8.f));
      ang = (float)(j < 8 ? prow : pcol) * inv;
    } else {
      const int jj = j - 16, f = jj & 15;
      const float inv = exp2f(-(float)f * (13.287712379549449f / 16.f));
      ang = (float)(jj < 16 ? prow : pcol) * inv;
    }
    float rev = ang * 0.15915494309189535f;
    rev -= floorf(rev);
    const float sn = __builtin_amdgcn_sinf(rev), cs = __builtin_amdgcn_cosf(rev);
    if (j < 16) { cosM[pos * 16 + j] = cs; sinM[pos * 16 + j] = sn; }
    else { cosG[pos * 32 + j - 16] = cs; sinG[pos * 32 + j - 16] = sn; }
  }
}

template <int MODE>
DI void ln_rows(const Params& p, int nrows, const float* srcL, const float* srcC, float* dstL, float* dstC,
                const float* lng, const float* lnb, const float* modl, int sh_off, int sc_off, u16* H, bool writeH, bool h16 = false) {
  const int lane = TIDX & 63;
  const int gw = (blockIdx.x * 256 + TIDX) >> 6, nw = (gridDim.x * 256) >> 6;
  for (int r = gw; r < nrows; r += nw) {
    const float* src = r < TL ? srcL + (size_t)r * D : srcC + (size_t)(r - TL) * D;
    f32x4 v[4];
#pragma unroll
    for (int i = 0; i < 4; ++i) v[i] = *(const f32x4*)(src + i * 256 + lane * 4);
    float s = 0.f;
#pragma unroll
    for (int i = 0; i < 4; ++i) s += v[i][0] + v[i][1] + v[i][2] + v[i][3];
    float mu = wave_sum(s) * (1.f / D);
    float q = 0.f;
#pragma unroll
    for (int i = 0; i < 4; ++i)
#pragma unroll
      for (int j = 0; j < 4; ++j) { const float d = v[i][j] - mu; q += d * d; }
    float rstd = rsqrtf(wave_sum(q) * (1.f / D) + EPS);
    if (MODE == 1) {
      float* dst = r < TL ? dstL + (size_t)r * D : dstC + (size_t)(r - TL) * D;
      s = 0.f;
#pragma unroll
      for (int i = 0; i < 4; ++i) {
        const f32x4 g = *(const f32x4*)(lng + i * 256 + lane * 4), b = *(const f32x4*)(lnb + i * 256 + lane * 4);
#pragma unroll
        for (int j = 0; j < 4; ++j) { v[i][j] = (v[i][j] - mu) * rstd * g[j] + b[j]; s += v[i][j]; }
        *(f32x4*)(dst + i * 256 + lane * 4) = v[i];
      }
      if (!writeH) continue;
      mu = wave_sum(s) * (1.f / D);
      q = 0.f;
#pragma unroll
      for (int i = 0; i < 4; ++i)
#pragma unroll
        for (int j = 0; j < 4; ++j) { const float d = v[i][j] - mu; q += d * d; }
      rstd = rsqrtf(wave_sum(q) * (1.f / D) + EPS);
    }
    const float* mrow = modl + row_mod(r) * 6144;
#pragma unroll
    for (int i = 0; i < 4; ++i) {
      const f32x4 sh = *(const f32x4*)(mrow + sh_off + i * 256 + lane * 4), sc = *(const f32x4*)(mrow + sc_off + i * 256 + lane * 4);
      f32x4 h;
#pragma unroll
      for (int j = 0; j < 4; ++j) h[j] = (v[i][j] - mu) * rstd * (1.f + sc[j]) + sh[j];
      if (h16) st_h4(H + (size_t)r * D + i * 256 + lane * 4, h); else st_bf4(H + (size_t)r * D + i * 256 + lane * 4, h);
    }
  }
}

DI void phase_inproj(const Params& p, int l, u16* smem) {
  const u16* H = (const u16*)(p.ws + OFF_H);
  const u16* W = (const u16*)(p.ws + OFF_W0);
  u16* Pmla = (u16*)(p.ws + OFF_PMLA);
  u16* Z = (u16*)(p.ws + OFF_Z);
  u16* XR = (u16*)(p.ws + OFF_XR);
  float* DT = (float*)(p.ws + OFF_DT);
  u16* Pgqa = (u16*)(p.ws + OFF_PGQA);
  u16* VtG = (u16*)(p.ws + OFF_VTG);
  const float* cosG = (const float*)(p.ws + OFF_COSG);
  const float* sinG = (const float*)(p.ws + OFF_SING);
  const int tid = TIDX, lane = tid & 63, wid = tid >> 6, wm = wid >> 1, wn = wid & 1, lr = lane & 15, lq = lane >> 4;
  constexpr int MT = T / 128, NT = WINP / 128;
  XCD_TILE_LOOP(MT, NT) {
    int mt, nt;
    tile_xcd(j_, blockIdx.x & 7, MT >> 3, NT, mt, nt);
    if (l == 1 && mt >= TL / 128 && (nt < 3 || (nt >= 6 && nt < 14) || (nt >= 27 && nt < 31))) continue;
    f32x4 acc[4][4];
    zero_acc<4>(acc);
    gemm_core<4>(H + (size_t)mt * 128 * 1024, 1024, W + (size_t)nt * 128 * 1024, 1024, 1024, acc, smem);
    const int rbase = mt * 128 + wm * 64 + lr;
    const int cw = wn * 64 + lq * 4;
    if (nt < 6) {
#pragma unroll
      for (int mi = 0; mi < 4; ++mi)
#pragma unroll
        for (int ni = 0; ni < 4; ++ni) {
          const int col = nt * 128 + cw + ni * 16;
          if (col < 672) st_bf4(Pmla + (size_t)(rbase + mi * 16) * 672 + col, acc[mi][ni]);
        }
    } else if (nt < 14) {
#pragma unroll
      for (int mi = 0; mi < 4; ++mi)
#pragma unroll
        for (int ni = 0; ni < 4; ++ni) st_bf4(Z + (size_t)(rbase + mi * 16) * 1024 + (nt - 6) * 128 + cw + ni * 16, acc[mi][ni]);
    } else if (nt < 26) {
#pragma unroll
      for (int mi = 0; mi < 4; ++mi)
#pragma unroll
        for (int ni = 0; ni < 4; ++ni) st_bf4(XR + (size_t)(rbase + mi * 16) * 1536 + (nt - 14) * 128 + cw + ni * 16, acc[mi][ni]);
    } else if (nt == 26) {
      if (wn == 0) {
#pragma unroll
        for (int mi = 0; mi < 4; ++mi)
#pragma unroll
          for (int ni = 0; ni < 2; ++ni) *(f32x4*)(DT + (size_t)(rbase + mi * 16) * 32 + lq * 4 + ni * 16) = acc[mi][ni];
      }
    } else if (nt < 32) {
      const float* g = (nt < 31) ? p.g_q_gqa + l * 64 : p.g_k_gqa + l * 64;
      const int dcol = (nt < 31) ? (nt - 27) * 128 + wn * 64 : 512 + wn * 64;
      f32x4 gv[4];
#pragma unroll
      for (int ni = 0; ni < 4; ++ni) gv[ni] = *(const f32x4*)(g + ni * 16 + lq * 4);
#pragma unroll
      for (int mi = 0; mi < 4; ++mi) {
        const int row = rbase + mi * 16;
        float ss = 0.f;
#pragma unroll
        for (int ni = 0; ni < 4; ++ni)
#pragma unroll
          for (int j = 0; j < 4; ++j) ss += acc[mi][ni][j] * acc[mi][ni][j];
        ss = quad_sum(ss);
        const float rstd = rsqrtf(ss * (1.f / 64.f) + EPS);
        f32x4 y[4];
#pragma unroll
        for (int ni = 0; ni < 4; ++ni)
#pragma unroll
          for (int j = 0; j < 4; ++j) y[ni][j] = acc[mi][ni][j] * rstd * gv[ni][j];
        if (row < TL) {
          const int pos = row & 4095;
#pragma unroll
          for (int ni = 0; ni < 2; ++ni) {
            const f32x4 cs = *(const f32x4*)(cosG + pos * 32 + ni * 16 + lq * 4), sn = *(const f32x4*)(sinG + pos * 32 + ni * 16 + lq * 4);
#pragma unroll
            for (int j = 0; j < 4; ++j) {
              const float x1 = y[ni][j], x2 = y[ni + 2][j];
              y[ni][j] = x1 * cs[j] - x2 * sn[j];
              y[ni + 2][j] = x1 * sn[j] + x2 * cs[j];
            }
          }
        }
#pragma unroll
        for (int ni = 0; ni < 4; ++ni) st_bf4(Pgqa + (size_t)row * 640 + dcol + ni * 16 + lq * 4, y[ni]);
      }
    } else {
#pragma unroll
      for (int mi = 0; mi < 4; ++mi) {
        const int row = rbase + mi * 16;
        const int b = row_batch(row), key = row_key(row);
        u16* vt = VtG + ((size_t)(b * 2 + wn) * 64) * NKEY + key;
#pragma unroll
        for (int ni = 0; ni < 4; ++ni)
#pragma unroll
          for (int j = 0; j < 4; ++j) vt[(size_t)(ni * 16 + lq * 4 + j) * NKEY] = f2bf(acc[mi][ni][j]);
      }
    }
  }
}

DI unsigned conv_word(unsigned w0, unsigned w1, unsigned w2, const float* cw, const float* cb, int ch) {
  const float lo = cw[ch] * bflo(w0) + cw[1536 + ch] * bflo(w1) + cw[3072 + ch] * bflo(w2) + cb[ch];
  const float hi = cw[ch + 1] * bfhi(w0) + cw[1536 + ch + 1] * bfhi(w1) + cw[3072 + ch + 1] * bfhi(w2) + cb[ch + 1];
  return pk2(siluf(lo), siluf(hi));
}
DI float sq_word(unsigned w) { const float x = bflo(w), y = bfhi(w); return x * x + y * y; }
DI void phase_c1(const Params& p, int l) {
  const u16* XR = (const u16*)(p.ws + OFF_XR);
  u16* XBC = (u16*)(p.ws + OFF_XBC);
  float* DT = (float*)(p.ws + OFF_DT);
  const u16* Pmla = (const u16*)(p.ws + OFF_PMLA);
  float* stats = (float*)(p.ws + OFF_STATS);
  const float* cw = p.conv_w + (size_t)l * 3 * 1536;
  const float* cb = p.conv_b + (size_t)l * 1536;
  const int gtid = blockIdx.x * 256 + TIDX, gn = gridDim.x * 256;
  for (int i = gtid; i < (T / 32) * 192; i += gn) {
    const int seg = i / 192, ch0 = (i % 192) * 8;
    const int row0 = seg * 32;
    bool first, last;
    if (row0 < TL) { const int pl = row0 & 4095; first = pl == 0; last = pl == 4096 - 32; }
    else { const int pj = (row0 - TL) & 255; first = pj == 0; last = pj == 256 - 32; }
    float w0[8], w1[8], w2[8], bb[8];
#pragma unroll
    for (int k = 0; k < 8; ++k) { w0[k] = cw[ch0 + k]; w1[k] = cw[1536 + ch0 + k]; w2[k] = cw[3072 + ch0 + k]; bb[k] = cb[ch0 + k]; }
    const uint4 z4 = make_uint4(0u, 0u, 0u, 0u);
    uint4 up = z4;
    if (!first) up = *(const uint4*)(XR + (size_t)(row0 - 1) * 1536 + ch0);
    uint4 uc = *(const uint4*)(XR + (size_t)row0 * 1536 + ch0);
#pragma unroll 4
    for (int r = 0; r < 32; ++r) {
      const int row = row0 + r;
      uint4 un = z4;
      if (r < 31 || !last) un = *(const uint4*)(XR + (size_t)(row + 1) * 1536 + ch0);
      uint4 ov;
      {
        const float lo = w0[0] * bflo(up.x) + w1[0] * bflo(uc.x) + w2[0] * bflo(un.x) + bb[0];
        const float hi = w0[1] * bfhi(up.x) + w1[1] * bfhi(uc.x) + w2[1] * bfhi(un.x) + bb[1];
        ov.x = pk2(siluf(lo), siluf(hi));
      }
      {
        const float lo = w0[2] * bflo(up.y) + w1[2] * bflo(uc.y) + w2[2] * bflo(un.y) + bb[2];
        const float hi = w0[3] * bfhi(up.y) + w1[3] * bfhi(uc.y) + w2[3] * bfhi(un.y) + bb[3];
        ov.y = pk2(siluf(lo), siluf(hi));
      }
      {
        const float lo = w0[4] * bflo(up.z) + w1[4] * bflo(uc.z) + w2[4] * bflo(un.z) + bb[4];
        const float hi = w0[5] * bfhi(up.z) + w1[5] * bfhi(uc.z) + w2[5] * bfhi(un.z) + bb[5];
        ov.z = pk2(siluf(lo), siluf(hi));
      }
      {
        const float lo = w0[6] * bflo(up.w) + w1[6] * bflo(uc.w) + w2[6] * bflo(un.w) + bb[6];
        const float hi = w0[7] * bfhi(up.w) + w1[7] * bfhi(uc.w) + w2[7] * bfhi(un.w) + bb[7];
        ov.w = pk2(siluf(lo), siluf(hi));
      }
      *(uint4*)(XBC + (size_t)row * 1536 + ch0) = ov;
      up = uc;
      uc = un;
    }
  }
  for (int i = gtid; i < T * 32; i += gn) {
    const float v = DT[i] + p.dt_bias[l * 32 + (i & 31)];
    const float e = __expf(-fabsf(v));
    const float lp = e < 0.01f ? e * (1.f - e * (0.5f - e * (1.f / 3.f))) : __logf(1.f + e);
    DT[i] = fmaxf(v, 0.f) + lp;
  }
  const int lane = TIDX & 63;
  const int gw = gtid >> 6, nw = gn >> 6;
  for (int r = gw; r < T; r += nw) {
    float sq = 0.f, sk = 0.f;
    if (lane < 48) {
      const uint4 u = *(const uint4*)(Pmla + (size_t)r * 672 + lane * 8);
      sq = sq_word(u.x) + sq_word(u.y) + sq_word(u.z) + sq_word(u.w);
    }
    if (lane < 32) {
      const uint4 u = *(const uint4*)(Pmla + (size_t)r * 672 + 384 + lane * 8);
      sk = sq_word(u.x) + sq_word(u.y) + sq_word(u.z) + sq_word(u.w);
    }
    sq = wave_sum(sq);
    sk = wave_sum(sk);
    if (lane == 0) {
      stats[r * 2] = rsqrtf(sq * (1.f / 384.f) + EPS);
      stats[r * 2 + 1] = rsqrtf(sk * (1.f / 256.f) + EPS);
    }
  }
}

DI void phase_c2(const Params& p, int l, u16* smem) {
  const u16* Pmla = (const u16*)(p.ws + OFF_PMLA);
  const u16* W0 = (const u16*)(p.ws + OFF_W0);
  u16* Qm = (u16*)(p.ws + OFF_QM);
  u16* Km = (u16*)(p.ws + OFF_KM);
  u16* VtM = (u16*)(p.ws + OFF_VTM);
  const float* stats = (const float*)(p.ws + OFF_STATS);
  const float* cosM = (const float*)(p.ws + OFF_COSM);
  const float* sinM = (const float*)(p.ws + OFF_SINM);
  const int tid = TIDX, lane = tid & 63, wid = tid >> 6, wm = wid >> 1, wn = wid & 1, lr = lane & 15, lq = lane >> 4;
  constexpr int MT = T / 128;
  XCD_TILE_LOOP(MT, 14) {
    f32x4 acc[4][4];
    zero_acc<4>(acc);
    int mt, nt;
    tile_xcd(j_, blockIdx.x & 7, MT >> 3, 14, mt, nt);
    if (l == 1 && mt >= TL / 128 && nt < 6) continue;
    if (nt < 6) {
      gemm_core<4>(Pmla + (size_t)mt * 128 * 672, 672, W0 + W0_UQ + (size_t)nt * 128 * 384, 384, 384, acc, smem);
      const int rbase = mt * 128 + wm * 64 + lr;
      const int c0 = nt * 128 + wn * 64;
      const int g0 = c0 >> 4;
#pragma unroll
      for (int mi = 0; mi < 4; ++mi) {
        const int row = rbase + mi * 16;
        const float rs = stats[row * 2];
        f32x4 y[4];
#pragma unroll
        for (int ni = 0; ni < 4; ++ni) y[ni] = acc[mi][ni] * rs;
        if (row < TL) {
          const int pos = row & 4095;
          const f32x4 cs = *(const f32x4*)(cosM + pos * 16 + lq * 4), sn = *(const f32x4*)(sinM + pos * 16 + lq * 4);
#pragma unroll
          for (int ni = 0; ni < 3; ++ni) {
            if ((g0 + ni) % 6 == 4) {
#pragma unroll
              for (int j = 0; j < 4; ++j) {
                const float x1 = y[ni][j], x2 = y[ni + 1][j];
                y[ni][j] = x1 * cs[j] - x2 * sn[j];
                y[ni + 1][j] = x1 * sn[j] + x2 * cs[j];
              }
            }
          }
        }
#pragma unroll
        for (int ni = 0; ni < 4; ++ni) st_bf4(Qm + (size_t)row * 768 + c0 + ni * 16 + lq * 4, y[ni]);
      }
    } else {
      nt -= 6;
      gemm_core<4>(Pmla + (size_t)mt * 128 * 672 + 384, 672, W0 + W0_UKV + (size_t)nt * 128 * 256, 256, 256, acc, smem);
      const int rbase = mt * 128 + wm * 64 + lr;
#pragma unroll
      for (int mi = 0; mi < 4; ++mi) {
        const int row = rbase + mi * 16;
        const float rs = stats[row * 2 + 1];
        if (wn == 0) {
#pragma unroll
          for (int ni = 0; ni < 4; ++ni) st_bf4(Km + (size_t)row * 768 + nt * 96 + ni * 16 + lq * 4, acc[mi][ni] * rs);
        } else {
          const int b = row_batch(row), key = row_key(row);
          u16* vt = VtM + ((size_t)(b * 8 + nt) * 64) * NKEY + key;
#pragma unroll
          for (int ni = 0; ni < 4; ++ni)
#pragma unroll
            for (int j = 0; j < 4; ++j) vt[(size_t)(ni * 16 + lq * 4 + j) * NKEY] = f2bf(acc[mi][ni][j] * rs);
        }
      }
    }
  }
  const int gtid = blockIdx.x * 256 + tid, gn = gridDim.x * 256;
  for (int i = gtid; i < T * 16; i += gn) {
    const int row = i >> 4, j = i & 15;
    float x1 = bf2f(Pmla[(size_t)row * 672 + 640 + j]), x2 = bf2f(Pmla[(size_t)row * 672 + 656 + j]);
    if (row < TL) {
      const int pos = row & 4095;
      const float cs = cosM[pos * 16 + j], sn = sinM[pos * 16 + j];
      const float a = x1 * cs - x2 * sn, b = x1 * sn + x2 * cs;
      x1 = a; x2 = b;
    }
    const u16 h1 = f2bf(x1), h2 = f2bf(x2);
#pragma unroll
    for (int h = 0; h < 8; ++h) {
      Km[(size_t)row * 768 + h * 96 + 64 + j] = h1;
      Km[(size_t)row * 768 + h * 96 + 80 + j] = h2;
    }
  }
}

template <int DQK, bool NOMAX>
DI void attn_item(const u16* __restrict__ Q, int ldq, int qoff, const u16* __restrict__ Kp, int ldk, int koff,
                  const u16* __restrict__ Vt, u16* __restrict__ Y, int yoff, int b, int qrow0, int nkt, float sl2, float c0, u16* smem) {
  constexpr int KS = DQK / 32;
  constexpr int KB = KS * 4096, STG = KB + 8192;
  char* sbase = (char*)smem;
  const int tid = TIDX, lane = tid & 63, wid = tid >> 6, lr = lane & 15, lq = lane >> 4;
  bf16x8 qf[2][KS];
#pragma unroll
  for (int qi = 0; qi < 2; ++qi)
#pragma unroll
    for (int ks = 0; ks < KS; ++ks)
      qf[qi][ks] = *(const bf16x8*)(Q + (size_t)(qrow0 + wid * 32 + qi * 16 + lr) * ldq + qoff + ks * 32 + lq * 8);
  f32x4 o[4][2];
#pragma unroll
  for (int i = 0; i < 4; ++i)
#pragma unroll
    for (int j = 0; j < 2; ++j) o[i][j] = (f32x4){0.f, 0.f, 0.f, 0.f};
  float mrun[2] = {-1e30f, -1e30f}, lrun[2] = {0.f, 0.f};
  const int drow = tid >> 2, dch = (tid & 3) ^ ((drow >> 2) & 3);
  const int wq = __builtin_amdgcn_readfirstlane(wid) * 1024;
  const u16* vsrc = Vt + (size_t)drow * NKEY + dch * 8;
#define ATT_ISSUE(KT, BUF)                                                                                           \
  {                                                                                                                  \
    const int kt_ = (KT) < nkt ? (KT) : nkt - 1;                                                                     \
    const int r0_ = kt_ < 4 ? TL + b * CTXL + kt_ * 64 : b * SEQ + (kt_ - 4) * 64;                                   \
    const u16* ksrc_ = Kp + (size_t)(r0_ + drow) * ldk + koff + dch * 8;                                             \
    _Pragma("unroll") for (int ks = 0; ks < KS; ++ks)                                                                \
        __builtin_amdgcn_global_load_lds((const GAS unsigned*)(ksrc_ + ks * 32),                                     \
                                         (LAS3 unsigned*)(sbase + (BUF) * STG + ks * 4096 + wq), 16, 0, 0);          \
    _Pragma("unroll") for (int u = 0; u < 2; ++u)                                                                    \
        __builtin_amdgcn_global_load_lds((const GAS unsigned*)(vsrc + kt_ * 64 + u * 32),                            \
                                         (LAS3 unsigned*)(sbase + (BUF) * STG + KB + u * 4096 + wq), 16, 0, 0);      \
  }
  const unsigned lbase = (unsigned)(size_t)((LAS3 char*)sbase);
  const unsigned kaddr = lbase + lr * 64 + ((lq ^ ((lr >> 2) & 3)) << 4);
  const unsigned vaddr0 = lbase + KB + lr * 64 + ((((lq >> 1)) ^ ((lr >> 2) & 3)) << 4) + (lq & 1) * 8;
  const unsigned vaddr1 = lbase + KB + lr * 64 + ((((lq >> 1) + 2) ^ ((lr >> 2) & 3)) << 4) + (lq & 1) * 8;
#define LDSR128(dst, addr, off) asm volatile("ds_read_b128 %0, %1 offset:%2" : "=v"(dst) : "v"(addr), "n"(off))
#define LDSR64(dst, addr, off) asm volatile("ds_read_b64 %0, %1 offset:%2" : "=v"(dst) : "v"(addr), "n"(off))
#define ATT_COMPUTE(BUF)                                                                                             \
  {                                                                                                                  \
    f32x4 s[4][2];                                                                                                   \
    _Pragma("unroll") for (int kk = 0; kk < 4; ++kk) {                                                               \
      bf16x8 kf[KS];                                                                                                 \
      LDSR128(kf[0], kaddr, (BUF) * STG + 0 * 4096 + kk * 1024);                                                     \
      LDSR128(kf[1], kaddr, (BUF) * STG + 1 * 4096 + kk * 1024);                                                     \
      if (KS == 3) LDSR128(kf[KS - 1], kaddr, (BUF) * STG + 2 * 4096 + kk * 1024);                                   \
      if (KS == 3) asm volatile("s_waitcnt lgkmcnt(0)" : "+v"(kf[0]), "+v"(kf[1]), "+v"(kf[KS - 1]));                \
      else asm volatile("s_waitcnt lgkmcnt(0)" : "+v"(kf[0]), "+v"(kf[1]));                                          \
      s[kk][0] = (f32x4){0.f, 0.f, 0.f, 0.f};                                                                        \
      s[kk][1] = (f32x4){0.f, 0.f, 0.f, 0.f};                                                                        \
      _Pragma("unroll") for (int ks = 0; ks < KS; ++ks) {                                                            \
        s[kk][0] = mma16<true>(kf[ks], qf[0][ks], s[kk][0]);                    \
        s[kk][1] = mma16<true>(kf[ks], qf[1][ks], s[kk][1]);                    \
      }                                                                                                              \
    }                                                                                                                \
    uint2 vlo[2][4], vhi[2][4];                                                                                      \
    _Pragma("unroll") for (int u = 0; u < 2; ++u) {                                                                  \
      LDSR64(vlo[u][0], vaddr0, (BUF) * STG + u * 4096 + 0 * 1024); LDSR64(vhi[u][0], vaddr1, (BUF) * STG + u * 4096 + 0 * 1024); \
      LDSR64(vlo[u][1], vaddr0, (BUF) * STG + u * 4096 + 1 * 1024); LDSR64(vhi[u][1], vaddr1, (BUF) * STG + u * 4096 + 1 * 1024); \
      LDSR64(vlo[u][2], vaddr0, (BUF) * STG + u * 4096 + 2 * 1024); LDSR64(vhi[u][2], vaddr1, (BUF) * STG + u * 4096 + 2 * 1024); \
      LDSR64(vlo[u][3], vaddr0, (BUF) * STG + u * 4096 + 3 * 1024); LDSR64(vhi[u][3], vaddr1, (BUF) * STG + u * 4096 + 3 * 1024); \
    }                                                                                                                \
    bf16x8 pf[2][2];                                                                                                 \
    _Pragma("unroll") for (int qi = 0; qi < 2; ++qi) {                                                               \
      float ps = 0.f;                                                                                                \
      float pv[4][4];                                                                                                \
      if (NOMAX) {                                                                                                   \
        _Pragma("unroll") for (int kk = 0; kk < 4; ++kk)                                                             \
            _Pragma("unroll") for (int j = 0; j < 4; ++j) {                                                          \
          const float e = __builtin_amdgcn_exp2f(s[kk][qi][j] * sl2 - c0);                                           \
          pv[kk][j] = e;                                                                                             \
          ps += e;                                                                                                   \
        }                                                                                                            \
      } else {                                                                                                       \
        float mx = -1e30f;                                                                                           \
        _Pragma("unroll") for (int kk = 0; kk < 4; ++kk)                                                             \
            _Pragma("unroll") for (int j = 0; j < 4; ++j) mx = fmaxf(mx, s[kk][qi][j]);                              \
        mx = quad_max(mx);                                                                                           \
        const float mnew = fmaxf(mrun[qi], mx * sl2);                                                                \
        const float alpha = __builtin_amdgcn_exp2f(mrun[qi] - mnew);                                                 \
        mrun[qi] = mnew;                                                                                             \
        _Pragma("unroll") for (int kk = 0; kk < 4; ++kk)                                                             \
            _Pragma("unroll") for (int j = 0; j < 4; ++j) {                                                          \
          const float e = __builtin_amdgcn_exp2f(s[kk][qi][j] * sl2 - mnew);                                         \
          pv[kk][j] = e;                                                                                             \
          ps += e;                                                                                                   \
        }                                                                                                            \
        if (__builtin_amdgcn_ballot_w64(alpha != 1.0f)) {                                                            \
          lrun[qi] *= alpha;                                                                                         \
          _Pragma("unroll") for (int dt = 0; dt < 4; ++dt) o[dt][qi] *= alpha;                                       \
        }                                                                                                            \
      }                                                                                                              \
      lrun[qi] += ps;                                                                                                \
      _Pragma("unroll") for (int u = 0; u < 2; ++u) {                                                                \
        union { bf16x8 v; unsigned w[4]; } pk;                                                                       \
        pk.w[0] = pk2(pv[2 * u][0], pv[2 * u][1]);                                                                   \
        pk.w[1] = pk2(pv[2 * u][2], pv[2 * u][3]);                                                                   \
        pk.w[2] = pk2(pv[2 * u + 1][0], pv[2 * u + 1][1]);                                                           \
        pk.w[3] = pk2(pv[2 * u + 1][2], pv[2 * u + 1][3]);                                                           \
        pf[qi][u] = pk.v;                                                                                            \
      }                                                                                                              \
    }                                                                                                                \
    asm volatile("s_waitcnt lgkmcnt(0)"                                                                              \
                 : "+v"(vlo[0][0]), "+v"(vlo[0][1]), "+v"(vlo[0][2]), "+v"(vlo[0][3]), "+v"(vhi[0][0]), "+v"(vhi[0][1]), \
                   "+v"(vhi[0][2]), "+v"(vhi[0][3]), "+v"(vlo[1][0]), "+v"(vlo[1][1]), "+v"(vlo[1][2]), "+v"(vlo[1][3]), \
                   "+v"(vhi[1][0]), "+v"(vhi[1][1]), "+v"(vhi[1][2]), "+v"(vhi[1][3]));                              \
    _Pragma("unroll") for (int u = 0; u < 2; ++u)                                                                    \
        _Pragma("unroll") for (int dt = 0; dt < 4; ++dt) {                                                           \
      union { bf16x8 v; uint2 h[2]; } vf;                                                                            \
      vf.h[0] = vlo[u][dt];                                                                                          \
      vf.h[1] = vhi[u][dt];                                                                                          \
      o[dt][0] = mma16<true>(vf.v, pf[0][u], o[dt][0]);                         \
      o[dt][1] = mma16<true>(vf.v, pf[1][u], o[dt][1]);                         \
    }                                                                                                                \
  }
  if (DQK == 64 && NOMAX) {
    f32x4 sc[4][2], sn[4][2];
#define ATT_KREAD(BUF)                                                                                               \
    _Pragma("unroll") for (int kk = 0; kk < 4; ++kk) {                                                               \
      LDSR128(kf[kk][0], kaddr, (BUF) * STG + 0 * 4096 + kk * 1024);                                                 \
      LDSR128(kf[kk][1], kaddr, (BUF) * STG + 1 * 4096 + kk * 1024);                                                 \
    }
#define ATT_VREAD(BUF)                                                                                               \
    _Pragma("unroll") for (int u = 0; u < 2; ++u) {                                                                  \
      LDSR64(vlo[u][0], vaddr0, (BUF) * STG + u * 4096 + 0 * 1024); LDSR64(vhi[u][0], vaddr1, (BUF) * STG + u * 4096 + 0 * 1024); \
      LDSR64(vlo[u][1], vaddr0, (BUF) * STG + u * 4096 + 1 * 1024); LDSR64(vhi[u][1], vaddr1, (BUF) * STG + u * 4096 + 1 * 1024); \
      LDSR64(vlo[u][2], vaddr0, (BUF) * STG + u * 4096 + 2 * 1024); LDSR64(vhi[u][2], vaddr1, (BUF) * STG + u * 4096 + 2 * 1024); \
      LDSR64(vlo[u][3], vaddr0, (BUF) * STG + u * 4096 + 3 * 1024); LDSR64(vhi[u][3], vaddr1, (BUF) * STG + u * 4096 + 3 * 1024); \
    }
#define ATT_KWAIT()                                                                                                  \
    asm volatile("s_waitcnt lgkmcnt(0)" : "+v"(kf[0][0]), "+v"(kf[0][1]), "+v"(kf[1][0]), "+v"(kf[1][1]), "+v"(kf[2][0]), "+v"(kf[2][1]), "+v"(kf[3][0]), "+v"(kf[3][1]));
#define ATT_VWAIT()                                                                                                  \
    asm volatile("s_waitcnt lgkmcnt(0)"                                                                              \
                 : "+v"(vlo[0][0]), "+v"(vlo[0][1]), "+v"(vlo[0][2]), "+v"(vlo[0][3]), "+v"(vhi[0][0]), "+v"(vhi[0][1]), \
                   "+v"(vhi[0][2]), "+v"(vhi[0][3]), "+v"(vlo[1][0]), "+v"(vlo[1][1]), "+v"(vlo[1][2]), "+v"(vlo[1][3]), \
                   "+v"(vhi[1][0]), "+v"(vhi[1][1]), "+v"(vhi[1][2]), "+v"(vhi[1][3]));
#define ATT_SMMA(s)                                                                                                  \
    _Pragma("unroll") for (int kk = 0; kk < 4; ++kk) {                                                               \
      s[kk][0] = (f32x4){0.f, 0.f, 0.f, 0.f};                                                                        \
      s[kk][1] = (f32x4){0.f, 0.f, 0.f, 0.f};                                                                        \
      _Pragma("unroll") for (int ks = 0; ks < 2; ++ks) {                                                             \
        s[kk][0] = mma16<true>(kf[kk][ks], qf[0][ks], s[kk][0]);                                                     \
        s[kk][1] = mma16<true>(kf[kk][ks], qf[1][ks], s[kk][1]);                                                     \
      }                                                                                                              \
    }
#define ATT_STEP2(KT, ST, SN)                                                                                        \
    if ((KT) < nkt) {                                                                                                \
      asm volatile("s_waitcnt vmcnt(0)" ::: "memory");                                                               \
      __builtin_amdgcn_s_barrier();                                                                                  \
      ATT_ISSUE((KT) + 2, ((ST) + 2) % 3)                                                                            \
      bf16x8 kf[4][2];                                                                                               \
      uint2 vlo[2][4], vhi[2][4];                                                                                    \
      if ((KT) + 1 < nkt) { ATT_KREAD(SN) } else { ATT_KREAD(ST) }                                                   \
      ATT_KWAIT()                                                                                                    \
      ATT_VREAD(ST)                                                                                                  \
      ATT_SMMA(sn)                                                                                                   \
      bf16x8 pf[2][2];                                                                                               \
      _Pragma("unroll") for (int qi = 0; qi < 2; ++qi) {                                                             \
        float ps = 0.f;                                                                                              \
        float pv[4][4];                                                                                              \
        _Pragma("unroll") for (int kk = 0; kk < 4; ++kk)                                                             \
            _Pragma("unroll") for (int j = 0; j < 4; ++j) {                                                          \
          const float e = __builtin_amdgcn_exp2f(sc[kk][qi][j] * sl2 - c0);                                          \
          pv[kk][j] = e;                                                                                             \
          ps += e;                                                                                                   \
        }                                                                                                            \
        lrun[qi] += ps;                                                                                              \
        _Pragma("unroll") for (int u = 0; u < 2; ++u) {                                                              \
          union { bf16x8 v; unsigned w[4]; } pk;                                                                     \
          pk.w[0] = pk2(pv[2 * u][0], pv[2 * u][1]);                                                                 \
          pk.w[1] = pk2(pv[2 * u][2], pv[2 * u][3]);                                                                 \
          pk.w[2] = pk2(pv[2 * u + 1][0], pv[2 * u + 1][1]);                                                         \
          pk.w[3] = pk2(pv[2 * u + 1][2], pv[2 * u + 1][3]);                                                         \
          pf[qi][u] = pk.v;                                                                                          \
        }                                                                                                            \
      }                                                                                                              \
      ATT_VWAIT()                                                                                                    \
      _Pragma("unroll") for (int u = 0; u < 2; ++u)                                                                  \
          _Pragma("unroll") for (int dt = 0; dt < 4; ++dt) {                                                         \
        union { bf16x8 v; uint2 h[2]; } vf;                                                                          \
        vf.h[0] = vlo[u][dt];                                                                                        \
        vf.h[1] = vhi[u][dt];                                                                                        \
        o[dt][0] = mma16<true>(vf.v, pf[0][u], o[dt][0]);                                                            \
        o[dt][1] = mma16<true>(vf.v, pf[1][u], o[dt][1]);                                                            \
      }                                                                                                              \
      _Pragma("unroll") for (int kk = 0; kk < 4; ++kk) { sc[kk][0] = sn[kk][0]; sc[kk][1] = sn[kk][1]; }             \
    }
    ATT_ISSUE(0, 0)
    ATT_ISSUE(1, 1)
    asm volatile("s_waitcnt vmcnt(%0)" ::"n"(KS + 2) : "memory");
    __builtin_amdgcn_s_barrier();
    {
      bf16x8 kf[4][2];
      ATT_KREAD(0)
      asm volatile("s_waitcnt lgkmcnt(0)" : "+v"(kf[0][0]), "+v"(kf[0][1]), "+v"(kf[1][0]), "+v"(kf[1][1]), "+v"(kf[2][0]), "+v"(kf[2][1]), "+v"(kf[3][0]), "+v"(kf[3][1]));
      ATT_SMMA(sc)
    }
    for (int kt = 0; kt < nkt; kt += 3) {
      ATT_STEP2(kt, 0, 1)
      ATT_STEP2(kt + 1, 1, 2)
      ATT_STEP2(kt + 2, 2, 0)
    }
    asm volatile("s_waitcnt vmcnt(0)" ::: "memory");
    __builtin_amdgcn_s_barrier();
#undef ATT_STEP2
#undef ATT_SMMA
#undef ATT_VWAIT
#undef ATT_KWAIT
#undef ATT_VREAD
#undef ATT_KREAD
  } else {
#define ATT_STEP(KT, ST)                                                                                             \
  if ((KT) < nkt) {                                                                                                  \
    asm volatile("s_waitcnt vmcnt(%0)" ::"n"(KS + 2) : "memory");                                                    \
    __builtin_amdgcn_s_barrier();                                                                                    \
    ATT_ISSUE((KT) + 2, ((ST) + 2) % 3)                                                                              \
    ATT_COMPUTE(ST)                                                                                                  \
  }
  ATT_ISSUE(0, 0)
  ATT_ISSUE(1, 1)
  for (int kt = 0; kt < nkt; kt += 3) {
    ATT_STEP(kt, 0)
    ATT_STEP(kt + 1, 1)
    ATT_STEP(kt + 2, 2)
  }
  asm volatile("s_waitcnt vmcnt(0)" ::: "memory");
  __builtin_amdgcn_s_barrier();
  }
#undef ATT_STEP
#undef ATT_COMPUTE
#undef ATT_ISSUE
#undef LDSR128
#undef LDSR64
#pragma unroll
  for (int qi = 0; qi < 2; ++qi) {
    const float lt = quad_sum(lrun[qi]);
    const float inv = 1.f / lt;
    const int row = qrow0 + wid * 32 + qi * 16 + lr;
#pragma unroll
    for (int dt = 0; dt < 4; ++dt) st_bf4(Y + (size_t)row * 512 + yoff + dt * 16 + lq * 4, o[dt][qi] * inv);
  }
}

DI void phase_attn(const Params& p, int l, bool with_ctx, u16* smem) {
  const u16* Qm = (const u16*)(p.ws + OFF_QM);
  const u16* Km = (const u16*)(p.ws + OFF_KM);
  const u16* VtM = (const u16*)(p.ws + OFF_VTM);
  u16* Ymla = (u16*)(p.ws + OFF_YMLA);
  const u16* Pgqa = (const u16*)(p.ws + OFF_PGQA);
  const u16* VtG = (const u16*)(p.ws + OFF_VTG);
  u16* Ygqa = (u16*)(p.ws + OFF_YGQA);
  const float sl2_mla = 0.10206207261596575f * 1.4426950408889634f;
  const float sl2_gqa = 0.125f * 1.4426950408889634f;
  float c0_gqa;
  {
    const int ln = TIDX & 63;
    float gq = fabsf(p.g_q_gqa[l * 64 + ln]), gk = fabsf(p.g_k_gqa[l * 64 + ln]);
#pragma unroll
    for (int o = 32; o > 0; o >>= 1) { gq = fmaxf(gq, __shfl_xor(gq, o)); gk = fmaxf(gk, __shfl_xor(gk, o)); }
    const float bound = 8.f * gq * gk * 1.01f;
    c0_gqa = fmaxf(0.f, bound - 10.f) * 1.4426950408889634f;
  }
  const int xcd = blockIdx.x & 7, slots = gridDim.x >> 3;
  const int per_xcd = 256 + (with_ctx ? 16 : 0);
  for (int q = blockIdx.x >> 3; q < per_xcd; q += slots) {
    int kind, b, h, qrow0, nkt;
    if (q < 128) {
      const int P = xcd * 4 + (q >> 5);
      kind = 0; b = P >> 3; h = P & 7;
      qrow0 = b * SEQ + (q & 31) * 128;
      nkt = NKEY / 64;
    } else if (q < 256) {
      const int q2 = q - 128;
      kind = 1; b = xcd >> 1; h = (xcd & 1) * 4 + (q2 >> 5);
      qrow0 = b * SEQ + (q2 & 31) * 128;
      nkt = NKEY / 64;
    } else {
      const int q3 = q - 256;
      kind = q3 & 1;
      const int j = xcd * 8 + (q3 >> 1);
      const int qt = j & 1; h = (j >> 1) & 7; b = j >> 4;
      qrow0 = TL + b * CTXL + qt * 128;
      nkt = CTXL / 64;
    }
    if (kind == 0)
      attn_item<96, false>(Qm, 768, h * 96, Km, 768, h * 96, VtM + (size_t)(b * 8 + h) * 64 * NKEY, Ymla, h * 64, b, qrow0, nkt, sl2_mla, 0.f, smem);
    else
      attn_item<64, true>(Pgqa, 640, h * 64, Pgqa, 640, 512 + (h >> 2) * 64, VtG + (size_t)(b * 2 + (h >> 2)) * 64 * NKEY, Ygqa, h * 64, b, qrow0, nkt, sl2_gqa, c0_gqa, smem);
  }
}

DI int chunk_row0(int b, int m) { return m < 2 ? TL + b * CTXL + m * 128 : b * SEQ + (m - 2) * 128; }
DI int chunk_scan_idx(int dir, int m) { return dir == 0 ? m : (m < 2 ? 1 - m : 35 - m); }
constexpr int LDX = 136;

DI void ssd_cums(const Params& p, int l, int h, int r0, float* sw, float* scum, float* sdt, float& tot_out) {
  const int lane = TIDX & 63, dir = TIDX >> 6;
  const float* DT = (const float*)(p.ws + OFF_DT);
  const float a = -__expf(p.a_log[l * 32 + dir * 16 + h]);
  const int k0 = lane * 2;
  const float d0 = DT[(size_t)(r0 + k0) * 32 + dir * 16 + h], d1 = DT[(size_t)(r0 + k0 + 1) * 32 + dir * 16 + h];
  const float v0 = a * d0, v1 = a * d1;
  float inc = v0 + v1;
#pragma unroll
  for (int off = 1; off < 64; off <<= 1) {
    const float t = __shfl_up(inc, off);
    if (lane >= off) inc += t;
  }
  const float c1 = inc, c0 = inc - v1;
  const float tot = __shfl(inc, 63);
  tot_out = tot;
  if (dir == 0) {
    sw[k0] = __expf(tot - c0) * d0;
    sw[k0 + 1] = __expf(tot - c1) * d1;
    scum[k0] = c0;
    scum[k0 + 1] = c1;
  } else {
    sw[128 + k0] = __expf(c0 - v0) * d0;
    sw[128 + k0 + 1] = __expf(c1 - v1) * d1;
    scum[128 + k0] = tot - c0 + v0;
    scum[128 + k0 + 1] = tot - c1 + v1;
  }
  sdt[dir * 128 + k0] = d0;
  sdt[dir * 128 + k0 + 1] = d1;
}

struct XRegs { uint4 u[4]; };
DI XRegs ssd_load_x(const u16* XBC, int r0, int h) {
  const int lane = TIDX & 63, wid = TIDX >> 6;
  const int k0 = lane * 2;
  XRegs x;
#pragma unroll
  for (int it = 0; it < 2; ++it) {
    const int cn = wid + 4 * it;
    x.u[2 * it] = *(const uint4*)(XBC + (size_t)(r0 + k0) * 1536 + h * 64 + cn * 8);
    x.u[2 * it + 1] = *(const uint4*)(XBC + (size_t)(r0 + k0 + 1) * 1536 + h * 64 + cn * 8);
  }
  return x;
}
DI void ssd_write_xt(const XRegs& x, const float* scale, u16* sXt) {
  const int lane = TIDX & 63, wid = TIDX >> 6;
  const int k0 = lane * 2;
#pragma unroll
  for (int it = 0; it < 2; ++it) {
    const int cn = wid + 4 * it;
    const uint4 u0 = x.u[2 * it], u1 = x.u[2 * it + 1];
#pragma unroll
    for (int dir = 0; dir < 2; ++dir) {
      const float s0 = scale[dir * 128 + k0], s1 = scale[dir * 128 + k0 + 1];
      u16* dst = sXt + dir * 64 * LDX + (cn * 8) * LDX + k0;
      *(unsigned*)(dst + 0 * LDX) = pk2(bflo(u0.x) * s0, bflo(u1.x) * s1);
      *(unsigned*)(dst + 1 * LDX) = pk2(bfhi(u0.x) * s0, bfhi(u1.x) * s1);
      *(unsigned*)(dst + 2 * LDX) = pk2(bflo(u0.y) * s0, bflo(u1.y) * s1);
      *(unsigned*)(dst + 3 * LDX) = pk2(bfhi(u0.y) * s0, bfhi(u1.y) * s1);
      *(unsigned*)(dst + 4 * LDX) = pk2(bflo(u0.z) * s0, bflo(u1.z) * s1);
      *(unsigned*)(dst + 5 * LDX) = pk2(bfhi(u0.z) * s0, bfhi(u1.z) * s1);
      *(unsigned*)(dst + 6 * LDX) = pk2(bflo(u0.w) * s0, bflo(u1.w) * s1);
      *(unsigned*)(dst + 7 * LDX) = pk2(bfhi(u0.w) * s0, bfhi(u1.w) * s1);
    }
  }
}

DI void phase_ssd_states(const Params& p, int l, u16* smem) {
  const u16* XBC = (const u16*)(p.ws + OFF_XBC);
  u16* S = (u16*)(p.ws + OFF_S);
  float* chdec = (float*)(p.ws + OFF_CHDEC);
  u16* sBt = smem;
  u16* sXt = smem + 128 * LDX;
  float* sw = (float*)(smem + 256 * LDX);
  float* scum = sw + 256;
  float* sdt = scum + 256;
  const int tid = TIDX, lane = tid & 63, wid = tid >> 6, lr = lane & 15, lq = lane >> 4;
  for (int it = blockIdx.x; it < NBATCH * NCH * 16; it += gridDim.x) {
    const int h = it & 15, m = (it >> 4) % NCH, b = it / (16 * NCH);
    const int r0 = chunk_row0(b, m), g = h >> 3;
    if (wid < 2) {
      float tot;
      ssd_cums(p, l, h, r0, sw, scum, sdt, tot);
      if (lane == 0) chdec[((wid * 4 + b) * NCH + chunk_scan_idx(wid, m)) * 16 + h] = __expf(tot);
    }
    {
      const int k0 = lane * 2;
#pragma unroll
      for (int i4 = 0; i4 < 4; ++i4) {
        const int cn = wid + 4 * i4;
        const uint4 u0 = *(const uint4*)(XBC + (size_t)(r0 + k0) * 1536 + 1024 + g * 128 + cn * 8);
        const uint4 u1 = *(const uint4*)(XBC + (size_t)(r0 + k0 + 1) * 1536 + 1024 + g * 128 + cn * 8);
        const unsigned a0[4] = {u0.x, u0.y, u0.z, u0.w}, a1[4] = {u1.x, u1.y, u1.z, u1.w};
        u16* dst = sBt + (cn * 8) * LDX + k0;
#pragma unroll
        for (int e = 0; e < 4; ++e) {
          *(unsigned*)(dst + (2 * e) * LDX) = (a0[e] & 0xffffu) | (a1[e] << 16);
          *(unsigned*)(dst + (2 * e + 1) * LDX) = (a0[e] >> 16) | (a1[e] & 0xffff0000u);
        }
      }
    }
    const XRegs xr = ssd_load_x(XBC, r0, h);
    __syncthreads();
    ssd_write_xt(xr, sw, sXt);
    __syncthreads();
    {
      const int dir = wid >> 1, nh = wid & 1;
      f32x4 acc[4][4];
      zero_acc<4>(acc);
      const u16* b_s = sBt + (nh * 64 + lr) * LDX + lq * 8;
      const u16* x_s = sXt + dir * 64 * LDX + lr * LDX + lq * 8;
#pragma unroll
      for (int ks = 0; ks < 4; ++ks) {
        bf16x8 bfv[4], xf[4];
#pragma unroll
        for (int i = 0; i < 4; ++i) {
          bfv[i] = *(const bf16x8*)(b_s + i * 16 * LDX + ks * 32);
          xf[i] = *(const bf16x8*)(x_s + i * 16 * LDX + ks * 32);
        }
#pragma unroll
        for (int pt = 0; pt < 4; ++pt)
#pragma unroll
          for (int nt = 0; nt < 4; ++nt)
            acc[pt][nt] = mma16<true>(bfv[nt], xf[pt], acc[pt][nt]);
      }
      u16* dst = S + ((((size_t)(dir * 4 + b) * NCH + chunk_scan_idx(dir, m)) * 16 + h) * 64) * 128;
#pragma unroll
      for (int pt = 0; pt < 4; ++pt)
#pragma unroll
        for (int nt = 0; nt < 4; ++nt) st_bf4(dst + (size_t)(pt * 16 + lr) * 128 + nh * 64 + nt * 16 + lq * 4, acc[pt][nt]);
    }
    __syncthreads();
  }
}

DI void phase_ssd_scan(const Params& p) {
  u16* S = (u16*)(p.ws + OFF_S);
  const float* chdec = (const float*)(p.ws + OFF_CHDEC);
  const int gtid = blockIdx.x * 256 + TIDX, gn = gridDim.x * 256;
  for (int i = gtid; i < 2 * 4 * 16 * 2048; i += gn) {
    const int e4 = i & 2047, h = (i >> 11) & 15, db = i >> 15;
    float hp[4] = {0.f, 0.f, 0.f, 0.f};
    u16* ptr = S + (((size_t)db * NCH) * 16 + h) * 8192 + e4 * 4;
    const float* dc = chdec + (db * NCH) * 16 + h;
    uint2 u[NCH];
#pragma unroll
    for (int c = 0; c < NCH; ++c) u[c] = *(const uint2*)(ptr + (size_t)c * 16 * 8192);
#pragma unroll
    for (int c = 0; c < NCH; ++c) {
      const float d = dc[c * 16];
      uint2 w;
      w.x = pk2(hp[0], hp[1]);
      w.y = pk2(hp[2], hp[3]);
      *(uint2*)(ptr + (size_t)c * 16 * 8192) = w;
      hp[0] = d * hp[0] + bflo(u[c].x);
      hp[1] = d * hp[1] + bfhi(u[c].x);
      hp[2] = d * hp[2] + bflo(u[c].y);
      hp[3] = d * hp[3] + bfhi(u[c].y);
    }
  }
}

DI void phase_ssd_y(const Params& p, int l, bool with_ctx, u16* smem) {
  const u16* XBC = (const u16*)(p.ws + OFF_XBC);
  const u16* S = (const u16*)(p.ws + OFF_S);
  u16* Yssd = (u16*)(p.ws + OFF_YSSD);
  u16* sB = smem;
  u16* sXt = smem + 128 * LDX;
  float* sw = (float*)(smem + 256 * LDX);
  float* scum = sw + 256;
  float* sdt = scum + 256;
  const int tid = TIDX, lane = tid & 63, wid = tid >> 6, lr = lane & 15, lq = lane >> 4;
  const int m_lo = with_ctx ? 0 : 2;
  const int nm = NCH - m_lo;
  for (int it = blockIdx.x; it < NBATCH * nm * 16; it += gridDim.x) {
    const int h = it & 15, m = m_lo + (it >> 4) % nm, b = it / (16 * nm);
    const int r0 = chunk_row0(b, m), g = h >> 3;
    if (wid < 2) {
      float tot;
      ssd_cums(p, l, h, r0, sw, scum, sdt, tot);
    }
    {
      const u16* hin0 = S + ((((size_t)(0 * 4 + b) * NCH + chunk_scan_idx(0, m)) * 16 + h) * 64) * 128;
      const u16* hin1 = S + ((((size_t)(1 * 4 + b) * NCH + chunk_scan_idx(1, m)) * 16 + h) * 64) * 128;
#pragma unroll
      for (int i = 0; i < 8; ++i) {
        const int id = tid + 256 * i, dir = id >> 10, rem = id & 1023, rr = rem >> 4, cc = rem & 15;
        *(uint4*)(sB + dir * 64 * LDX + rr * LDX + cc * 8) = *(const uint4*)((dir ? hin1 : hin0) + rr * 128 + cc * 8);
      }
    }
    const XRegs xr = ssd_load_x(XBC, r0, h);
    __syncthreads();
    ssd_write_xt(xr, sdt, sXt);
    f32x4 acc0[2][4], acc1[2][4];
#pragma unroll
    for (int qi = 0; qi < 2; ++qi) {
      const int q = wid * 32 + qi * 16 + lr;
      bf16x8 cf[4];
#pragma unroll
      for (int ks = 0; ks < 4; ++ks) cf[ks] = *(const bf16x8*)(XBC + (size_t)(r0 + q) * 1536 + 1280 + g * 128 + ks * 32 + lq * 8);
#pragma unroll
      for (int dir = 0; dir < 2; ++dir) {
        f32x4 t[4];
#pragma unroll
        for (int pt = 0; pt < 4; ++pt) t[pt] = (f32x4){0.f, 0.f, 0.f, 0.f};
#pragma unroll
        for (int ks = 0; ks < 4; ++ks)
#pragma unroll
          for (int pt = 0; pt < 4; ++pt) {
            const bf16x8 hf = *(const bf16x8*)(sB + dir * 64 * LDX + (pt * 16 + lr) * LDX + ks * 32 + lq * 8);
            t[pt] = mma16<true>(hf, cf[ks], t[pt]);
          }
        const float e = __expf(scum[dir * 128 + q]);
#pragma unroll
        for (int pt = 0; pt < 4; ++pt) { if (qi == 0) acc0[dir][pt] = t[pt] * e; else acc1[dir][pt] = t[pt] * e; }
      }
      __builtin_amdgcn_sched_barrier(0);
    }
    __syncthreads();
#pragma unroll
    for (int i = 0; i < 8; ++i) {
      const int id = tid + 256 * i, rr = id >> 4, cc = id & 15;
      *(uint4*)(sB + rr * LDX + cc * 8) = *(const uint4*)(XBC + (size_t)(r0 + rr) * 1536 + 1024 + g * 128 + cc * 8);
    }
    __syncthreads();
    const float dsk = p.d_skip[l * 16 + h];
#pragma unroll 1
    for (int qi = 0; qi < 2; ++qi) {
      const int q = wid * 32 + qi * 16 + lr;
      f32x4 acc[2][4];
#pragma unroll
      for (int dir = 0; dir < 2; ++dir)
#pragma unroll
        for (int pt = 0; pt < 4; ++pt)
#pragma unroll
          for (int j = 0; j < 4; ++j) acc[dir][pt][j] = qi == 0 ? acc0[dir][pt][j] : acc1[dir][pt][j];
      const float cq0 = scum[q], cq1 = scum[128 + q];
      bf16x8 cf[4];
#pragma unroll
      for (int ks = 0; ks < 4; ++ks) cf[ks] = *(const bf16x8*)(XBC + (size_t)(r0 + q) * 1536 + 1280 + g * 128 + ks * 32 + lq * 8);
#pragma unroll 1
      for (int u = 0; u < 4; ++u) {
        f32x4 sc[2];
#pragma unroll
        for (int half = 0; half < 2; ++half) {
          sc[half] = (f32x4){0.f, 0.f, 0.f, 0.f};
#pragma unroll
          for (int ks = 0; ks < 4; ++ks) {
            const bf16x8 bfv = *(const bf16x8*)(sB + ((2 * u + half) * 16 + lr) * LDX + ks * 32 + lq * 8);
            sc[half] = mma16<true>(bfv, cf[ks], sc[half]);
          }
        }
#pragma unroll
        for (int dir = 0; dir < 2; ++dir) {
          const float cq = dir == 0 ? cq0 : cq1;
          union { bf16x8 v; unsigned w[4]; } gp;
#pragma unroll
          for (int half = 0; half < 2; ++half) {
            const int k0 = (2 * u + half) * 16 + lq * 4;
            const f32x4 ck4 = *(const f32x4*)(scum + dir * 128 + k0);
            float gv[4];
#pragma unroll
            for (int j = 0; j < 4; ++j) {
              const int k = k0 + j;
              const bool ok = dir == 0 ? (k <= q) : (k >= q);
              const float arg = ok ? (cq - ck4[j]) * 1.4426950408889634f : -1.0e30f;
              gv[j] = sc[half][j] * __builtin_amdgcn_exp2f(arg);
            }
            gp.w[half * 2] = pk2(gv[0], gv[1]);
            gp.w[half * 2 + 1] = pk2(gv[2], gv[3]);
          }
#pragma unroll
          for (int pt = 0; pt < 4; ++pt) {
            union { bf16x8 v; uint2 hh[2]; } xf;
            const u16* xs = sXt + dir * 64 * LDX + (pt * 16 + lr) * LDX + u * 32 + lq * 4;
            xf.hh[0] = *(const uint2*)(xs);
            xf.hh[1] = *(const uint2*)(xs + 16);
            acc[dir][pt] = mma16<true>(xf.v, gp.v, acc[dir][pt]);
          }
        }
      }
#pragma unroll
      for (int pt = 0; pt < 4; ++pt) {
        const uint2 xu = *(const uint2*)(XBC + (size_t)(r0 + q) * 1536 + h * 64 + pt * 16 + lq * 4);
        f32x4 y = acc[0][pt] + acc[1][pt];
        y[0] += dsk * bflo(xu.x);
        y[1] += dsk * bfhi(xu.x);
        y[2] += dsk * bflo(xu.y);
        y[3] += dsk * bfhi(xu.y);
        st_bf4(Yssd + (size_t)(r0 + q) * 1024 + h * 64 + pt * 16 + lq * 4, y);
      }
    }
    __syncthreads();
  }
}

DI void phase_ssd_finish(const Params& p, int l, int nrows) {
  u16* Yssd = (u16*)(p.ws + OFF_YSSD);
  const u16* Z = (const u16*)(p.ws + OFF_Z);
  const float* g = p.g_ssd + l * 1024;
  const int lane = TIDX & 63;
  const int gw = (blockIdx.x * 256 + TIDX) >> 6, nw = (gridDim.x * 256) >> 6;
  for (int r = gw; r < nrows; r += nw) {
    float v[16];
    float ss = 0.f;
#pragma unroll
    for (int i = 0; i < 2; ++i) {
      const uint4 yu = *(const uint4*)(Yssd + (size_t)r * 1024 + i * 512 + lane * 8);
      const uint4 zu = *(const uint4*)(Z + (size_t)r * 1024 + i * 512 + lane * 8);
      const unsigned ya[4] = {yu.x, yu.y, yu.z, yu.w}, za[4] = {zu.x, zu.y, zu.z, zu.w};
#pragma unroll
      for (int k = 0; k < 4; ++k) {
        const float a = bflo(ya[k]) * siluf(bflo(za[k])), bb = bfhi(ya[k]) * siluf(bfhi(za[k]));
        v[i * 8 + 2 * k] = a;
        v[i * 8 + 2 * k + 1] = bb;
        ss += a * a + bb * bb;
      }
    }
    const float rstd = rsqrtf(wave_sum(ss) * (1.f / 1024.f) + EPS);
#pragma unroll
    for (int i = 0; i < 2; ++i) {
      const f32x4 g0 = *(const f32x4*)(g + i * 512 + lane * 8), g1 = *(const f32x4*)(g + i * 512 + lane * 8 + 4);
      uint4 o;
      o.x = pk2(v[i * 8 + 0] * rstd * g0[0], v[i * 8 + 1] * rstd * g0[1]);
      o.y = pk2(v[i * 8 + 2] * rstd * g0[2], v[i * 8 + 3] * rstd * g0[3]);
      o.z = pk2(v[i * 8 + 4] * rstd * g1[0], v[i * 8 + 5] * rstd * g1[1]);
      o.w = pk2(v[i * 8 + 6] * rstd * g1[2], v[i * 8 + 7] * rstd * g1[3]);
      *(uint4*)(Yssd + (size_t)r * 1024 + i * 512 + lane * 8) = o;
    }
  }
}

DI void phase_merge(const Params& p, int l, int nrows, const float* srcL, const float* srcC, u16* smem) {
  const u16* H = (const u16*)(p.ws + OFF_H2);
  const u16* W0 = (const u16*)(p.ws + OFF_W0);
  const float* modl = (const float*)(p.ws + OFF_MODV) + (size_t)l * 5 * 6144;
  const float* bg = p.b_gate + l * 3072;
  float* XC = (float*)(p.ws + OFF_XC);
  const int tid = TIDX, lane = tid & 63, wid = tid >> 6, wm = wid >> 1, wn = wid & 1, lr = lane & 15, lq = lane >> 4;
  const int MT = nrows / 128;
  XCD_TILE_LOOP(MT, 8) {
    int mt, nt;
    tile_xcd(j_, blockIdx.x & 7, MT >> 3, 8, mt, nt);
    const int n0 = nt * 128;
#pragma unroll 1
    for (int br = 0; br < 3; ++br) {
      const u16* Ybr = (const u16*)(p.ws + (br == 0 ? OFF_YMLA : (br == 1 ? OFF_YSSD : OFF_YGQA)));
      const int ldyb = br == 1 ? 1024 : 512, koffb = br == 0 ? 0 : (br == 1 ? 512 : 1536);
      f32x4 gt[4][4];
      zero_acc<4>(gt);
      gemm_core<4>(H + (size_t)mt * 128 * 1024, 1024, W0 + (size_t)(br * 1024 + n0) * 1024, 1024, 1024, gt, smem);
      uint2 gp[4][4];
#pragma unroll
      for (int ni = 0; ni < 4; ++ni) {
        const f32x4 bv = *(const f32x4*)(bg + br * 1024 + n0 + wn * 64 + ni * 16 + lq * 4);
#pragma unroll
        for (int mi = 0; mi < 4; ++mi) {
          gp[mi][ni].x = pk2(sigmf(gt[mi][ni][0] + bv[0]), sigmf(gt[mi][ni][1] + bv[1]));
          gp[mi][ni].y = pk2(sigmf(gt[mi][ni][2] + bv[2]), sigmf(gt[mi][ni][3] + bv[3]));
          asm volatile("" : "+v"(gp[mi][ni].x), "+v"(gp[mi][ni].y));
        }
      }
      f32x4 ya[4][4];
      zero_acc<4>(ya);
      gemm_core<4>(Ybr + (size_t)mt * 128 * ldyb, ldyb, W0 + W0_OUT + (size_t)n0 * 2048 + koffb, 2048, ldyb, ya, smem);
#pragma unroll
      for (int mi = 0; mi < 4; ++mi) {
        const int row = mt * 128 + wm * 64 + mi * 16 + lr;
        const float* src = row < TL ? srcL + (size_t)row * D : srcC + (size_t)(row - TL) * D;
        float* dst = row < TL ? p.out + (size_t)row * D : XC + (size_t)(row - TL) * D;
        const float* g1 = modl + row_mod(row) * 6144 + 2048;
#pragma unroll
        for (int ni = 0; ni < 4; ++ni) {
          const int col = n0 + wn * 64 + ni * 16 + lq * 4;
          const f32x4 gv = *(const f32x4*)(g1 + col);
          f32x4 base;
          if (br == 0) base = ALPHA * *(const f32x4*)(src + col);
          else base = *(const f32x4*)(dst + col);
          f32x4 gf;
          gf[0] = bflo(gp[mi][ni].x); gf[1] = bfhi(gp[mi][ni].x); gf[2] = bflo(gp[mi][ni].y); gf[3] = bfhi(gp[mi][ni].y);
          *(f32x4*)(dst + col) = base + gv * (gf * ya[mi][ni]);
        }
        __builtin_amdgcn_sched_barrier(0);
      }
    }
  }
}

DI void phase_ffn_in(const Params& p, int nrows, u16* smem) {
  const u16* H = (const u16*)(p.ws + OFF_H2);
  const u16* W0 = (const u16*)(p.ws + OFF_W0);
  u16* ACT = (u16*)(p.ws + OFF_ACT);
  const int tid = TIDX, lane = tid & 63, wid = tid >> 6, wm = wid >> 1, wn = wid & 1, lr = lane & 15, lq = lane >> 4;
  const int MT = nrows / 128;
  XCD_TILE_LOOP(MT, 44) {
    int mt, nt;
    tile_xcd(j_, blockIdx.x & 7, MT >> 3, 44, mt, nt);
    f32x4 acc[4][4];
    zero_acc<4>(acc);
    gemm_core<4, true>(H + (size_t)mt * 128 * 1024, 1024, W0 + (size_t)nt * 128 * 1024, 1024, 1024, acc, smem);
#pragma unroll
    for (int mi = 0; mi < 4; ++mi) {
      const int row = mt * 128 + wm * 64 + mi * 16 + lr;
#pragma unroll
      for (int pr = 0; pr < 2; ++pr) {
        const int q = (nt * 128 + wn * 64 + pr * 32) >> 5;
        f32x4 v;
#pragma unroll
        for (int j = 0; j < 4; ++j) v[j] = siluf(acc[mi][2 * pr][j]) * acc[mi][2 * pr + 1][j];
        st_h4(ACT + (size_t)row * FFN_H + q * 16 + lq * 4, v);
      }
    }
  }
}

DI void phase_ffn_out(const Params& p, int l, int nrows, u16* smem) {
  const u16* ACT = (const u16*)(p.ws + OFF_ACT);
  const u16* W1 = (const u16*)(p.ws + OFF_W1);
  const float* modl = (const float*)(p.ws + OFF_MODV) + (size_t)l * 5 * 6144;
  float* XC = (float*)(p.ws + OFF_XC);
  const int tid = TIDX, lane = tid & 63, wid = tid >> 6, wm = wid >> 1, wn = wid & 1, lr = lane & 15, lq = lane >> 4;
  const int MT = nrows / 128;
  XCD_TILE_LOOP(MT, 8) {
    int mt, nt;
    tile_xcd(j_, blockIdx.x & 7, MT >> 3, 8, mt, nt);
    f32x4 acc[4][4];
    zero_acc<4>(acc);
    gemm_core<4, true>(ACT + (size_t)mt * 128 * FFN_H, FFN_H, W1 + (size_t)nt * 128 * FFN_H, FFN_H, FFN_H, acc, smem);
#pragma unroll
    for (int mi = 0; mi < 4; ++mi) {
      const int row = mt * 128 + wm * 64 + mi * 16 + lr;
      float* xp = row < TL ? p.out + (size_t)row * D : XC + (size_t)(row - TL) * D;
      const float* g2 = modl + row_mod(row) * 6144 + 5120;
#pragma unroll
      for (int ni = 0; ni < 4; ++ni) {
        const int col = nt * 128 + wn * 64 + ni * 16 + lq * 4;
        const f32x4 xv = *(const f32x4*)(xp + col), gv = *(const f32x4*)(g2 + col);
        *(f32x4*)(xp + col) = ALPHA * xv + gv * acc[mi][ni];
      }
    }
  }
}

#define XB_TMO      128
#define XB_XCNT(j)  (256  + 64 * (j))
#define XB_XSUB(j)  (1280 + 64 * (j))
#define XB_XGEN(j)  (2304 + 64 * (j))
#define XB_TOP      3328
#define XB_TOPGEN   3392
#define XCD_BAR_WORDS 3456
#define XB_SPIN_CAP (1u << 20)
#define LAS __attribute__((address_space(3)))
DI unsigned xb_ld(unsigned* p) { return __hip_atomic_load(p, __ATOMIC_RELAXED, __HIP_MEMORY_SCOPE_AGENT); }
DI unsigned xb_add(unsigned* p, unsigned v) { return __hip_atomic_fetch_add(p, v, __ATOMIC_RELAXED, __HIP_MEMORY_SCOPE_AGENT); }
DI unsigned xb_xcc_id() { return (unsigned)__builtin_amdgcn_s_getreg((3 << 11) | 20) & 0xFu; }
#define XB_SPIN(cond, bar) do { unsigned _sp = 0; while (cond) { __builtin_amdgcn_s_sleep(1); \
    if ((++_sp & 255u) == 0u) { if (xb_ld(&(bar)[XB_TMO])) break; if (_sp > XB_SPIN_CAP) { atomicAdd(&(bar)[XB_TMO], 1u); break; } } } } while (0)
struct XcdBarrier { unsigned* bar; unsigned x; volatile LAS unsigned* st; };
DI XcdBarrier xcd_barrier_post(unsigned* bar, volatile LAS unsigned* st) {
  XcdBarrier b; b.bar = bar; b.x = xb_xcc_id(); b.st = st;
  if (threadIdx.x == 0) (void)xb_add(&bar[XB_XCNT(b.x)], 1u);
  return b;
}
DI void xcd_barrier_complete(unsigned* bar, unsigned x, unsigned& nloc, unsigned& nx) {
  const unsigned G = gridDim.x * gridDim.y * gridDim.z;
  unsigned sum, cnt, mine, sp = 0u;
  for (;;) {
    sum = 0u; cnt = 0u; mine = 0u;
#pragma unroll
    for (unsigned j = 0; j < 16; ++j) { const unsigned c = xb_ld(&bar[XB_XCNT(j)]); sum += c; cnt += (c > 0u) ? 1u : 0u; mine = (j == x) ? c : mine; }
    if (sum == G) break;
    __builtin_amdgcn_s_sleep(1);
    if ((++sp & 255u) == 0u) { if (xb_ld(&bar[XB_TMO])) break; if (sp > XB_SPIN_CAP) { atomicAdd(&bar[XB_TMO], 1u); break; } }
  }
  nloc = mine > 0u ? mine : 1u; nx = cnt > 0u ? cnt : 1u;
}
DI void xcd_barrier(const XcdBarrier& b) {
  asm volatile("s_waitcnt vmcnt(0)" ::: "memory");
  __syncthreads();
  if (threadIdx.x == 0) {
    unsigned* bar = b.bar;
    __builtin_amdgcn_s_waitcnt(0);
    unsigned nloc = b.st[0], nx = b.st[1];
    if (nloc == 0u) { xcd_barrier_complete(bar, b.x, nloc, nx); b.st[0] = nloc; b.st[1] = nx; }
    const unsigned old = xb_add(&bar[XB_XSUB(b.x)], 1u);
    const unsigned gen = old / nloc;
    if (old + 1u == (gen + 1u) * nloc) {
      __builtin_amdgcn_fence(__ATOMIC_RELEASE, "agent");
      asm volatile("s_waitcnt vmcnt(0)" ::: "memory");
      const unsigned og = xb_add(&bar[XB_TOP], 1u);
      const unsigned tg = og / nx;
      if (og + 1u == (tg + 1u) * nx) xb_add(&bar[XB_TOPGEN], 1u);
      else XB_SPIN(xb_ld(&bar[XB_TOPGEN]) == tg, bar);
      __builtin_amdgcn_fence(__ATOMIC_ACQUIRE, "agent");
      xb_add(&bar[XB_XGEN(b.x)], 1u);
      asm volatile("s_waitcnt vmcnt(0)" ::: "memory");
    } else {
      XB_SPIN(xb_ld(&bar[XB_XGEN(b.x)]) == gen, bar);
      __builtin_amdgcn_fence(__ATOMIC_ACQUIRE, "agent");
      asm volatile("s_waitcnt vmcnt(0)" ::: "memory");
    }
  }
  __syncthreads();
}

constexpr int NPHASE = 2 + 13 * 2;

__global__ void __launch_bounds__(256, 2) fwd_megakernel(Params p) {
  __shared__ __attribute__((aligned(16))) unsigned char smem_raw[SMEM_BYTES];
  u16* smem = (u16*)smem_raw;
  float* smf = (float*)smem_raw;
  cg::grid_group grid = cg::this_grid();
  __shared__ uint4 xb_words;
  if (threadIdx.x == 0) xb_words = make_uint4(0u, 0u, 0u, 0u);
  __syncthreads();
  XcdBarrier xb = xcd_barrier_post((unsigned*)(p.ws + OFF_BAR), (volatile LAS unsigned*)&xb_words);
  if (p.ph0 < 0) grid.sync();
  const float* modv = (const float*)(p.ws + OFF_MODV);
  float* XC = (float*)(p.ws + OFF_XC);
  for (int ph = p.ph0; ph < p.ph1; ++ph) {
    if (ph == 0) {
      phase_prologue(p, smf);
      cvt_inproj_set(p, 0, smf);
    } else if (ph == 1) {
      ln_rows<0>(p, T, p.x, p.ctx, nullptr, nullptr, nullptr, nullptr, modv, 0, 1024, (u16*)(p.ws + OFF_H), true);
    } else {
      const int l = (ph - 2) / 13, s = (ph - 2) % 13;
      const bool with_ctx = (l == 0);
      const int nrows = with_ctx ? T : TL;
      const float* modl = modv + (size_t)l * 5 * 6144;
      const float* srcL = (l == 0) ? p.x : p.out;
      const float* srcC = (l == 0) ? p.ctx : XC;
      switch (s) {
        case 0: phase_inproj(p, l, smem); break;
        case 1: phase_c1(p, l); break;
        case 2: phase_c2(p, l, smem); break;
        case 3: phase_attn(p, l, with_ctx, smem); break;
        case 4: phase_ssd_states(p, l, smem); break;
        case 5: phase_ssd_scan(p); cvt_merge_set(p, l, smf); break;
        case 6: phase_ssd_y(p, l, with_ctx, smem); break;
        case 7:
          phase_ssd_finish(p, l, nrows);
          ln_rows<0>(p, nrows, srcL, srcC, nullptr, nullptr, nullptr, nullptr, modl, 0, 1024, (u16*)(p.ws + OFF_H2), true);
          break;
        case 8: phase_merge(p, l, nrows, srcL, srcC, smem); break;
        case 9:
          ln_rows<1>(p, nrows, p.out, XC, p.out, XC, p.ln1_g + l * D, p.ln1_b + l * D, modl, 3072, 4096, (u16*)(p.ws + OFF_H2), true, true);
          cvt_ffn_set(p, l, smf);
          break;
        case 10: phase_ffn_in(p, nrows, smem); break;
        case 11: phase_ffn_out(p, l, nrows, smem); break;
        case 12:
          if (l == 0) {
            ln_rows<1>(p, nrows, p.out, XC, p.out, XC, p.ln2_g + l * D, p.ln2_b + l * D, modv + (size_t)5 * 6144, 0, 1024, (u16*)(p.ws + OFF_H), true);
            cvt_inproj_set(p, 1, smf);
          } else {
            ln_rows<1>(p, nrows, p.out, XC, p.out, XC, p.ln2_g + l * D, p.ln2_b + l * D, modl, 0, 1024, nullptr, false);
          }
          break;
      }
    }
    if (ph + 1 < p.ph1) xcd_barrier(xb);
  }
#ifdef DBG_N
  grid.sync();
  {
    const u16* w16 = (const u16*)p.ws;
    const size_t n16 = WS_END / 2;
    const int gtid = blockIdx.x * 256 + TIDX, gn = gridDim.x * 256;
    for (int i = gtid; i < TL * D; i += gn) {
      unsigned s = 0;
      for (int j = 0; j < 8; ++j) {
        const size_t a = (size_t)i + (size_t)j * (size_t)(TL * D);
        if (a < n16) s += w16[a] * (unsigned)(j + 1);
      }
      p.out[i] = (float)(s & 0xFFFFFu);
    }
  }
#endif
}

extern "C" void kernel_launch(void* const* d_in, const int* in_sizes, int n_in, void* d_out, int out_size, void* d_ws,
                              size_t ws_size, hipStream_t stream) {
  static int grid_blocks = 0;
  if (!grid_blocks) {
    int dev = 0, cus = 0, per_cu = 0;
    (void)hipGetDevice(&dev);
    (void)hipDeviceGetAttribute(&cus, hipDeviceAttributeMultiprocessorCount, dev);
    (void)hipOccupancyMaxActiveBlocksPerMultiprocessor(&per_cu, fwd_megakernel, 256, 0);
    if (per_cu > 2) per_cu = 2;
    if (per_cu < 1) per_cu = 1;
    grid_blocks = cus * per_cu;
  }
  if (n_in != 27 || ws_size < WS_TOTAL || out_size != TL * D) {
    fprintf(stderr, "kernel_launch: unexpected shapes (n_in %d, out %d, ws %zu < %zu)\n", n_in, out_size, ws_size, (size_t)WS_END);
    return;
  }
  Params p{};
  const float** pp = (const float**)&p;
  for (int i = 0; i < 27; ++i) pp[i] = (const float*)d_in[i];
  p.out = (float*)d_out;
  p.ws = (char*)d_ws;
  p.ph0 = 0;
#ifdef DBG_N
  p.ph1 = DBG_N;
#else
  p.ph1 = NPHASE;
#endif
  (void)hipMemsetAsync((char*)d_ws + OFF_BAR, 0, XCD_BAR_WORDS * 4, stream);
  void* args[] = {&p};
  hipError_t e = hipLaunchCooperativeKernel((void*)fwd_megakernel, dim3(grid_blocks), dim3(256), args, 0, stream);
  if (e != hipSuccess) fprintf(stderr, "cooperative launch failed: %s (grid %d)\n", hipGetErrorString(e), grid_blocks);
}
```
